# Optimizing an MI355X kernel written in HIP

```python
import jax, jax.numpy as jnp
from jax import lax
import numpy as np

D_MODEL = 1024
BATCH = 2
SEQ = 16384
DEPTH = 1
DEC_BATCH = 32
DEC_SEQ = 32
PAST_LEN = 2048

CHUNK = 64
LEFT_CHUNKS = 8
BAND = (LEFT_CHUNKS + 1) * CHUNK
HEAD_DIM = 64
ATTN_WIDTH = D_MODEL // 2
ATTN_HEADS = ATTN_WIDTH // HEAD_DIM
LRU_WIDTH = D_MODEL // 2
LRU_BLOCKS = 8
LRU_BLOCK = LRU_WIDTH // LRU_BLOCKS
CONV_WIDTH = 4
LRU_C = 8.0
REL_CLIP = 128
REL_SIZE = REL_CLIP + CHUNK
MIX_WIDTH = ATTN_WIDTH + LRU_WIDTH
IN_WIDTH = 3 * ATTN_WIDTH + 2 * LRU_WIDTH
D_FF = -(-8 * D_MODEL // (3 * 256)) * 256
PLE_DIM = 256
EPS = 1e-6
NEG = -1e30
SCALE = HEAD_DIM ** -0.5

kernel_name = 'hymba_rglru_chunkband_stream_step'


def rmsnorm(x, g):
    xf = x.astype(jnp.float32)
    y = xf * lax.rsqrt(jnp.mean(xf * xf, axis=-1, keepdims=True) + EPS)
    return (y * g.astype(jnp.float32)).astype(x.dtype)


def rel_bias(rel_table, rel):
    idx = jnp.clip(rel, -REL_CLIP, CHUNK - 1) + REL_CLIP
    return rel_table.astype(jnp.float32)[:, idx]


def softmax_attend(q, k, v, bias, mask=None):
    s = jnp.einsum('bqhd,bkhd->bhqk', q.astype(jnp.float32), k.astype(jnp.float32)) * SCALE + bias
    if mask is not None:
        s = jnp.where(mask, s, NEG)
    p = jax.nn.softmax(s, axis=-1)
    return jnp.einsum('bhqk,bkhd->bqhd', p, v.astype(jnp.float32)).astype(q.dtype)


def chunk_band_attention(q, k, v, rel_table):
    b_, s_ = q.shape[:2]
    n_chunks = s_ // CHUNK
    pad = LEFT_CHUNKS * CHUNK
    kp = jnp.pad(k, ((0, 0), (pad, 0), (0, 0), (0, 0)))
    vp = jnp.pad(v, ((0, 0), (pad, 0), (0, 0), (0, 0)))
    kpos = jnp.arange(BAND) - pad
    qpos = jnp.arange(CHUNK)
    bias = rel_bias(rel_table, kpos[None, :] - qpos[:, None])

    def one_chunk(c):
        start = c * CHUNK
        qb = lax.dynamic_slice_in_dim(q, start, CHUNK, axis=1)
        kb = lax.dynamic_slice_in_dim(kp, start, BAND, axis=1)
        vb = lax.dynamic_slice_in_dim(vp, start, BAND, axis=1)
        valid = (start + kpos) >= pad
        return softmax_attend(qb, kb, vb, bias, valid[None, None, None, :])

    out = lax.map(one_chunk, jnp.arange(n_chunks))
    return jnp.moveaxis(out, 0, 1).reshape(b_, s_, ATTN_WIDTH)


def cached_band_attention(q, k, v, cache_k, cache_v, rel_table):
    b_, t = q.shape[:2]
    n_cache = cache_k.shape[1]
    keys = jnp.concatenate([cache_k.astype(k.dtype), k], axis=1)
    vals = jnp.concatenate([cache_v.astype(v.dtype), v], axis=1)
    kpos = jnp.concatenate([jnp.arange(n_cache) - n_cache, jnp.arange(t)])
    bias = rel_bias(rel_table, kpos[None, :] - jnp.arange(t)[:, None])
    return softmax_attend(q, keys, vals, bias).reshape(b_, t, ATTN_WIDTH)


def causal_conv(xb, state, conv_w, conv_b):
    t = xb.shape[1]
    xp = jnp.concatenate([state.astype(xb.dtype), xb], axis=1)
    y = conv_b + sum(xp[:, j:j + t] * conv_w[j] for j in range(CONV_WIDTH))
    return y, xp[:, -(CONV_WIDTH - 1):]


def rglru(xc, h0, w_rgate, b_rgate, w_igate, b_igate, lru_lambda):
    b_, t = xc.shape[:2]
    xf = xc.astype(jnp.float32)
    xblk = xf.reshape(b_, t, LRU_BLOCKS, LRU_BLOCK)
    r = jax.nn.sigmoid(jnp.einsum('btnk,nkj->btnj', xblk, w_rgate.astype(jnp.float32)).reshape(b_, t, LRU_WIDTH) + b_rgate.astype(jnp.float32))
    ig = jax.nn.sigmoid(jnp.einsum('btnk,nkj->btnj', xblk, w_igate.astype(jnp.float32)).reshape(b_, t, LRU_WIDTH) + b_igate.astype(jnp.float32))
    log_a = -LRU_C * r * jax.nn.softplus(-lru_lambda.astype(jnp.float32))
    a = jnp.exp(log_a)
    u = jnp.sqrt(-jnp.expm1(2.0 * log_a)) * (ig * xf)
    u = u.at[:, 0].add(a[:, 0] * h0.astype(jnp.float32))

    def combine(left, right):
        a_l, u_l = left
        a_r, u_r = right
        return a_l * a_r, a_r * u_l + u_r

    _, hs = lax.associative_scan(combine, (a, u), axis=1)
    return hs.astype(xc.dtype), hs[:, -1]


def trunk_layer(h, p, attend, conv_state, lru_state, g_mix, w_in, conv_w, conv_b, w_rgate, b_rgate,
                w_igate, b_igate, lru_lambda, g_attn_out, g_lru_out, w_out, g_ffn, w_ffn_gate,
                w_ffn_up, w_ffn_down, g_ple, w_ple_gate, w_ple_proj):
    b_, t = h.shape[:2]
    xn = rmsnorm(h, g_mix)
    proj = xn @ w_in
    q, k, v, xr, gr = jnp.split(proj, [ATTN_WIDTH, 2 * ATTN_WIDTH, 3 * ATTN_WIDTH, 3 * ATTN_WIDTH + LRU_WIDTH], axis=-1)
    hd_shape = (b_, t, ATTN_HEADS, HEAD_DIM)
    attn_out, k_new, v_new = attend(q.reshape(hd_shape), k.reshape(hd_shape), v.reshape(hd_shape))
    xc, conv_new = causal_conv(xr, conv_state, conv_w, conv_b)
    hs, lru_new = rglru(xc, lru_state, w_rgate, b_rgate, w_igate, b_igate, lru_lambda)
    lru_out = hs * jax.nn.gelu(gr, approximate=True)
    mixed = jnp.concatenate([rmsnorm(attn_out, g_attn_out), rmsnorm(lru_out, g_lru_out)], axis=-1)
    h = h + mixed @ w_out
    hn = rmsnorm(h, g_ffn)
    h = h + (jax.nn.silu(hn @ w_ffn_gate) * (hn @ w_ffn_up)) @ w_ffn_down
    gate = jax.nn.sigmoid(rmsnorm(h, g_ple) @ w_ple_gate)
    h = h + (p.astype(h.dtype) @ w_ple_proj) * gate
    return h, k_new, v_new, conv_new, lru_new


def setup_inputs(seed: int = 0) -> dict:
    key = jax.random.key(seed)
    ks = jax.random.split(key, 32)
    f32 = jnp.float32

    def nrm(k, shape, scale=1.0):
        return jax.random.normal(k, shape, f32) * scale

    kv_len = min(LEFT_CHUNKS * CHUNK, PAST_LEN)
    a_c = jax.random.uniform(ks[20], (DEPTH, LRU_WIDTH), f32, 0.9, 0.999)
    base = a_c ** (1.0 / LRU_C)
    lru_lambda = jnp.log(base) - jnp.log1p(-base)
    return {
        'x_prompt': nrm(ks[0], (BATCH, SEQ, D_MODEL)),
        'x_sample': nrm(ks[1], (DEC_BATCH, DEC_SEQ, D_MODEL)),
        'p_prompt': nrm(ks[2], (DEPTH, BATCH, SEQ, PLE_DIM)),
        'p_sample': nrm(ks[3], (DEPTH, DEC_BATCH, DEC_SEQ, PLE_DIM)),
        'cache_k': nrm(ks[4], (DEPTH, DEC_BATCH, kv_len, ATTN_HEADS, HEAD_DIM)),
        'cache_v': nrm(ks[5], (DEPTH, DEC_BATCH, kv_len, ATTN_HEADS, HEAD_DIM)),
        'state_conv': nrm(ks[6], (DEPTH, DEC_BATCH, CONV_WIDTH - 1, LRU_WIDTH)),
        'state_h': nrm(ks[7], (DEPTH, DEC_BATCH, LRU_WIDTH), 0.5),
        'g_mix': 1.0 + nrm(ks[8], (DEPTH, D_MODEL), 0.02),
        'w_in': nrm(ks[9], (DEPTH, D_MODEL, IN_WIDTH), D_MODEL ** -0.5),
        'conv_w': nrm(ks[10], (DEPTH, CONV_WIDTH, LRU_WIDTH), CONV_WIDTH ** -0.5),
        'conv_b': nrm(ks[11], (DEPTH, LRU_WIDTH), 0.01),
        'w_rgate': nrm(ks[12], (DEPTH, LRU_BLOCKS, LRU_BLOCK, LRU_BLOCK), LRU_BLOCK ** -0.5),
        'b_rgate': nrm(ks[13], (DEPTH, LRU_WIDTH), 0.01),
        'w_igate': nrm(ks[14], (DEPTH, LRU_BLOCKS, LRU_BLOCK, LRU_BLOCK), LRU_BLOCK ** -0.5),
        'b_igate': nrm(ks[15], (DEPTH, LRU_WIDTH), 0.01),
        'lru_lambda': lru_lambda,
        'rel_bias_table': nrm(ks[16], (DEPTH, ATTN_HEADS, REL_SIZE), 0.1),
        'g_attn_out': 1.0 + nrm(ks[17], (DEPTH, ATTN_WIDTH), 0.02),
        'g_lru_out': 1.0 + nrm(ks[18], (DEPTH, LRU_WIDTH), 0.02),
        'w_out': nrm(ks[19], (DEPTH, MIX_WIDTH, D_MODEL), MIX_WIDTH ** -0.5),
        'g_ffn': 1.0 + nrm(ks[21], (DEPTH, D_MODEL), 0.02),
        'w_ffn_gate': nrm(ks[22], (DEPTH, D_MODEL, D_FF), D_MODEL ** -0.5),
        'w_ffn_up': nrm(ks[23], (DEPTH, D_MODEL, D_FF), D_MODEL ** -0.5),
        'w_ffn_down': nrm(ks[24], (DEPTH, D_FF, D_MODEL), D_FF ** -0.5),
        'g_ple': 1.0 + nrm(ks[25], (DEPTH, D_MODEL), 0.02),
        'w_ple_gate': nrm(ks[26], (DEPTH, D_MODEL, D_MODEL), D_MODEL ** -0.5),
        'w_ple_proj': nrm(ks[27], (DEPTH, PLE_DIM, D_MODEL), PLE_DIM ** -0.5),
        'g_final': 1.0 + nrm(ks[28], (D_MODEL,), 0.02),
    }


def reference(x_prompt, x_sample, p_prompt, p_sample, cache_k, cache_v, state_conv, state_h,
              g_mix, w_in, conv_w, conv_b, w_rgate, b_rgate, w_igate, b_igate, lru_lambda,
              rel_bias_table, g_attn_out, g_lru_out, w_out, g_ffn, w_ffn_gate, w_ffn_up,
              w_ffn_down, g_ple, w_ple_gate, w_ple_proj, g_final):
    hp = x_prompt
    hsmp = x_sample
    n_keep = min(LEFT_CHUNKS * CHUNK, x_prompt.shape[1])
    kp_l, vp_l, cp_l, hp_l = [], [], [], []
    ks_l, vs_l, cs_l, hs_l = [], [], [], []
    for i in range(DEPTH):
        lw = (g_mix[i], w_in[i], conv_w[i], conv_b[i], w_rgate[i], b_rgate[i], w_igate[i], b_igate[i],
              lru_lambda[i], g_attn_out[i], g_lru_out[i], w_out[i], g_ffn[i], w_ffn_gate[i],
              w_ffn_up[i], w_ffn_down[i], g_ple[i], w_ple_gate[i], w_ple_proj[i])
        table = rel_bias_table[i]

        def attend_prompt(q, k, v, table=table):
            return chunk_band_attention(q, k, v, table), k[:, -n_keep:], v[:, -n_keep:]

        def attend_sample(q, k, v, table=table, ck=cache_k[i], cv=cache_v[i]):
            return cached_band_attention(q, k, v, ck, cv, table), k, v

        zero_conv = jnp.zeros((hp.shape[0], CONV_WIDTH - 1, LRU_WIDTH), hp.dtype)
        zero_h = jnp.zeros((hp.shape[0], LRU_WIDTH), jnp.float32)
        hp, k1, v1, c1, r1 = trunk_layer(hp, p_prompt[i], attend_prompt, zero_conv, zero_h, *lw)
        hsmp, k2, v2, c2, r2 = trunk_layer(hsmp, p_sample[i], attend_sample, state_conv[i], state_h[i], *lw)
        kp_l.append(k1); vp_l.append(v1); cp_l.append(c1); hp_l.append(r1)
        ks_l.append(k2); vs_l.append(v2); cs_l.append(c2); hs_l.append(r2)
    y_prompt = rmsnorm(hp, g_final)
    y_sample = rmsnorm(hsmp, g_final)
    return (y_prompt, y_sample,
            jnp.stack(kp_l), jnp.stack(vp_l), jnp.stack(cp_l), jnp.stack(hp_l),
            jnp.stack(ks_l), jnp.stack(vs_l), jnp.stack(cs_l), jnp.stack(hs_l))
```

```cpp
#include <hip/hip_runtime.h>
#include <hip/hip_cooperative_groups.h>
#include <cstdio>
#include <cstdint>
namespace cg = cooperative_groups;
namespace pg8 {
#define PG8_LAS __attribute__((address_space(3)))
typedef unsigned short bf16_t;
typedef short bf16x8 __attribute__((ext_vector_type(8)));
typedef float f32x4 __attribute__((ext_vector_type(4)));
typedef unsigned u32x4 __attribute__((ext_vector_type(4)));
constexpr int BM = 256, BK = 64, HALF = 128, HTB = HALF * BK * 2  , STAGE_BYTES = 8 * HTB, NXCD = 8, WGM = 8;

__host__ __device__ __forceinline__ int lds_byte(int r, int c) { const int st = (r >> 4) * 2 + (c >> 5), rr = r & 15, cc = c & 31, ob = rr * 64 + cc * 2; return st * 1024 + (ob ^ (((ob >> 9) & 1) << 5)); }
__host__ __device__ __forceinline__ void stage_rc(int b, int& R, int& C) { const int st = b / 1024, sb = b % 1024, swz = sb ^ (((sb >> 9) & 1) << 5); R = (st >> 1) * 16 + swz / 64; C = (st & 1) * 32 + (swz % 64) / 2; }
__host__ __device__ __forceinline__ int perm32(int rho) { const int n = rho >> 4, i = rho & 15; return 8 * (i >> 2) + 4 * n + (i & 3); }

struct Unit { int pm, pn; };
struct Gemm { const bf16_t* A; const bf16_t* Bt; int M, N, K; };

struct StaticOrder {
    int nM, nN, nwg, G, c;
    __host__ __device__ void init(int M, int N, int G_, int c_) { nM = M / BM; nN = N / BM; nwg = nM * nN; G = G_; c = c_; }
    __host__ __device__ bool next(int i, Unit& u) const {
        const long L = (long)i * G + c; if (L >= nwg) return false;
        int wgid = (int)L; { const int q = nwg / NXCD, r = nwg % NXCD, xcd = wgid % NXCD, off = wgid / NXCD; wgid = (xcd < r ? xcd * (q + 1) : r * (q + 1) + (xcd - r) * q) + off; }
        const int nig = WGM * nN, gid = wgid / nig, fm = gid * WGM, gsz = (nM - fm) < WGM ? (nM - fm) : WGM;
        u.pm = fm + ((wgid % nig) % gsz); u.pn = (wgid % nig) / gsz; return true;
    }
    __device__ __forceinline__ void a_ready(const Unit&) const {}
    __device__ __forceinline__ void done(const Unit&) const {}
};
__device__ __forceinline__ unsigned cvt_pk_bf16(float lo, float hi) { unsigned r; asm volatile("v_cvt_pk_bf16_f32 %0, %1, %2" : "=v"(r) : "v"(lo), "v"(hi)); return r; }
template <class Epi, class Sched, bool ALIGN_EPI = false, bool SP2 = false>
__device__ __forceinline__ void gemm_phase(PG8_LAS unsigned char* lds, const Gemm g, const Sched& S, const Epi& E, const int wave_s) {
    int lane_o = __builtin_amdgcn_mbcnt_hi(~0u, __builtin_amdgcn_mbcnt_lo(~0u, 0u)); asm volatile("" : "+v"(lane_o));
    const int wid = wave_s, lane = lane_o, tid = wave_s * 64 + lane_o, wr = wid >> 2, wc = wid & 3, fr = lane & 15, fq = lane >> 4;
    int K_o = g.K; asm volatile("" : "+s"(K_o));
    const int K = K_o, nt = K / BK;
    unsigned voffA[2], voffB[2];
#pragma unroll
    for (int i = 0; i < 2; ++i) { int R, C; stage_rc(tid * 16 + i * 8192, R, C); const int Rb = Epi::PERM ? ((R & ~31) + perm32(R & 31)) : R;
        voffA[i] = (unsigned)(R * K + C) * 2u; voffB[i] = (unsigned)(Rb * K + C) * 2u; }
    const size_t kstep = (size_t)(BK * 2);
    const size_t hstep = (size_t)HALF * K * 2;
    const size_t tstep = 2 * hstep;
    const unsigned ldsw = (unsigned)wid * 1024u;
    const int aoff = lds_byte(wr * 64 + fr, fq * 8), boff = lds_byte(wc * 32 + fr, fq * 8);
#define PG8_SA(b, h) (((b) * 2 + (h)) * HTB)
#define PG8_SB(b, h) ((4 + (b) * 2 + (h)) * HTB)
#define PG8_STAGE(bufoff, gbase, voff) do { _Pragma("unroll") for (int _i = 0; _i < 2; ++_i) \
        __builtin_amdgcn_global_load_lds((const unsigned*)((const char*)(gbase) + (voff)[_i]), (PG8_LAS unsigned*)(lds + (bufoff) + ldsw + _i * 8192), 16, 0, 0); } while (0)
#define PG8_LDA(dst, b, h) do { _Pragma("unroll") for (int m = 0; m < 4; ++m) _Pragma("unroll") for (int k = 0; k < 2; ++k) dst[m][k] = *(const PG8_LAS bf16x8*)(lds + PG8_SA(b, h) + aoff + m * 2048 + k * 1024); } while (0)
#define PG8_LDB(dst, b, h) do { _Pragma("unroll") for (int n = 0; n < 2; ++n) _Pragma("unroll") for (int k = 0; k < 2; ++k) dst[n][k] = *(const PG8_LAS bf16x8*)(lds + PG8_SB(b, h) + boff + n * 2048 + k * 1024); } while (0)
#define PG8_MMA(ai, bj, At, Bt) do { __builtin_amdgcn_s_setprio(1); _Pragma("unroll") for (int m = 0; m < 4; ++m) _Pragma("unroll") for (int n = 0; n < 2; ++n) _Pragma("unroll") for (int k = 0; k < 2; ++k) \
        acc[ai][bj][m][n] = __builtin_amdgcn_mfma_f32_16x16x32_bf16(Bt[n][k], At[m][k], acc[ai][bj][m][n], 0, 0, 0); __builtin_amdgcn_s_setprio(0); } while (0)
#define PG8_WAIT_V(n) asm volatile("s_waitcnt vmcnt(" #n ")" ::: "memory")
#define PG8_WAIT_L(n) asm volatile("s_waitcnt lgkmcnt(" #n ")" ::: "memory")
#define PG8_BAR __builtin_amdgcn_s_barrier()
#define PG8_SCHED __builtin_amdgcn_sched_barrier(0)
    Unit cur, nxt; int ui = 0;
    if (!S.next(0, cur)) return;
    f32x4 acc[2][2][4][2];
#pragma unroll
    for (int a = 0; a < 2; ++a)
#pragma unroll
        for (int b = 0; b < 2; ++b)
#pragma unroll
            for (int m = 0; m < 4; ++m)
#pragma unroll
                for (int n = 0; n < 2; ++n) acc[a][b][m][n] = (f32x4){0.f, 0.f, 0.f, 0.f};
    bf16x8 At[4][2], B0[2][2], B1[2][2];
    const char* cA = (const char*)g.A + (size_t)cur.pm * tstep; const char* cB = (const char*)g.Bt + (size_t)cur.pn * tstep;
    S.a_ready(cur);
    if constexpr (SP2) {
        PG8_STAGE(PG8_SB(0, 0), cB, voffB); PG8_STAGE(PG8_SB(0, 1), cB + hstep, voffB); PG8_STAGE(PG8_SA(0, 0), cA, voffA); PG8_STAGE(PG8_SA(0, 1), cA + hstep, voffA);
        if (wr == 1) PG8_BAR;
        PG8_WAIT_V(2); PG8_BAR;
        PG8_STAGE(PG8_SB(1, 0), cB + kstep, voffB); PG8_STAGE(PG8_SA(1, 0), cA + kstep, voffA); PG8_STAGE(PG8_SB(1, 1), cB + hstep + kstep, voffB);
        PG8_WAIT_V(6); PG8_BAR;
    } else {
        PG8_STAGE(PG8_SB(0, 0), cB, voffB); PG8_STAGE(PG8_SA(0, 0), cA, voffA); PG8_STAGE(PG8_SB(0, 1), cB + hstep, voffB); PG8_STAGE(PG8_SA(0, 1), cA + hstep, voffA);
        if (wr == 1) PG8_BAR;
        PG8_WAIT_V(4); PG8_BAR;
        PG8_STAGE(PG8_SB(1, 0), cB + kstep, voffB); PG8_STAGE(PG8_SA(1, 0), cA + kstep, voffA); PG8_STAGE(PG8_SB(1, 1), cB + hstep + kstep, voffB);
        PG8_WAIT_V(6); PG8_BAR;
    }
    for (;;) {
        const bool has_next = S.next(ui + 1, nxt);
        const char* nA = has_next ? (const char*)g.A + (size_t)nxt.pm * tstep : cA; const char* nB = has_next ? (const char*)g.Bt + (size_t)nxt.pn * tstep : cB;
        for (int t = 0; t < nt; t += 2) {
            const bool last = (t == nt - 2);
            const char* a1 = cA + (size_t)(t + 1) * kstep;
            const char* a2 = last ? nA : cA + (size_t)(t + 2) * kstep; const char* b2 = last ? nB : cB + (size_t)(t + 2) * kstep;
            const char* a3 = a2 + kstep; const char* b3 = b2 + kstep;
            if (last && has_next) S.a_ready(nxt);
            if constexpr (SP2) {
            PG8_LDB(B0, 0, 0); PG8_LDB(B1, 0, 1); PG8_SCHED; PG8_LDA(At, 0, 0); PG8_STAGE(PG8_SA(1, 1), a1 + hstep, voffA);
            PG8_WAIT_V(8); PG8_WAIT_L(0); PG8_BAR; PG8_MMA(0, 0, At, B0); PG8_MMA(0, 1, At, B1); PG8_BAR; PG8_SCHED;
            PG8_LDA(At, 0, 1); PG8_STAGE(PG8_SB(0, 0), b2, voffB); PG8_STAGE(PG8_SB(0, 1), b2 + hstep, voffB); PG8_STAGE(PG8_SA(0, 0), a2, voffA);
            PG8_WAIT_V(8); PG8_WAIT_L(0); PG8_BAR; PG8_MMA(1, 0, At, B0); PG8_MMA(1, 1, At, B1); PG8_BAR; PG8_SCHED;
            PG8_LDB(B0, 1, 0); PG8_LDB(B1, 1, 1); PG8_SCHED; PG8_LDA(At, 1, 0); PG8_STAGE(PG8_SA(0, 1), a2 + hstep, voffA);
            PG8_WAIT_V(8); PG8_WAIT_L(0); PG8_BAR; PG8_MMA(0, 0, At, B0); PG8_MMA(0, 1, At, B1); PG8_BAR; PG8_SCHED;
            PG8_LDA(At, 1, 1); PG8_STAGE(PG8_SB(1, 0), b3, voffB); PG8_STAGE(PG8_SB(1, 1), b3 + hstep, voffB); PG8_STAGE(PG8_SA(1, 0), a3, voffA);
            PG8_WAIT_V(8); PG8_WAIT_L(0); PG8_BAR; PG8_MMA(1, 0, At, B0); PG8_MMA(1, 1, At, B1); PG8_BAR; PG8_SCHED;
            } else {
            PG8_LDB(B0, 0, 0); PG8_SCHED; PG8_LDA(At, 0, 0); PG8_STAGE(PG8_SA(1, 1), a1 + hstep, voffA);
            PG8_WAIT_L(8); PG8_BAR; PG8_WAIT_L(0); PG8_MMA(0, 0, At, B0); PG8_BAR; PG8_SCHED;
            PG8_LDB(B1, 0, 1); PG8_STAGE(PG8_SB(0, 0), b2, voffB);
            PG8_BAR; PG8_WAIT_L(0); PG8_MMA(0, 1, At, B1); PG8_BAR;
            PG8_LDA(At, 0, 1); PG8_STAGE(PG8_SA(0, 0), a2, voffA);
            PG8_BAR; PG8_WAIT_L(0); PG8_MMA(1, 0, At, B0); PG8_BAR; PG8_SCHED;
            PG8_STAGE(PG8_SB(0, 1), b2 + hstep, voffB);
            PG8_WAIT_V(6); PG8_BAR; PG8_MMA(1, 1, At, B1); PG8_BAR;
            PG8_LDB(B0, 1, 0); PG8_SCHED; PG8_LDA(At, 1, 0); PG8_STAGE(PG8_SA(0, 1), a2 + hstep, voffA);
            PG8_WAIT_L(8); PG8_BAR; PG8_WAIT_L(0); PG8_MMA(0, 0, At, B0); PG8_BAR; PG8_SCHED;
            PG8_LDB(B1, 1, 1); PG8_STAGE(PG8_SB(1, 0), b3, voffB);
            PG8_BAR; PG8_WAIT_L(0); PG8_MMA(0, 1, At, B1); PG8_BAR;
            PG8_LDA(At, 1, 1); PG8_STAGE(PG8_SA(1, 0), a3, voffA);
            PG8_BAR; PG8_WAIT_L(0); PG8_MMA(1, 0, At, B0); PG8_BAR; PG8_SCHED;
            PG8_STAGE(PG8_SB(1, 1), b3 + hstep, voffB);
            PG8_WAIT_V(6); PG8_BAR; PG8_MMA(1, 1, At, B1); PG8_BAR;
            }
        }
        if constexpr (ALIGN_EPI) { if (wr == 0) PG8_BAR; }
        if constexpr (!Epi::AFTER_DRAIN) { E(acc, cur, wr, wc, fr, fq); S.done(cur); }
        if (!has_next) break;
#pragma unroll
        for (int a = 0; a < 2; ++a)
#pragma unroll
            for (int b = 0; b < 2; ++b)
#pragma unroll
                for (int m = 0; m < 4; ++m)
#pragma unroll
                    for (int n = 0; n < 2; ++n) acc[a][b][m][n] = (f32x4){0.f, 0.f, 0.f, 0.f};
        cur = nxt; cA = nA; cB = nB; ++ui;
        if constexpr (ALIGN_EPI) { if (wr == 1) PG8_BAR; }
    }
    PG8_WAIT_V(0);
    if constexpr (!ALIGN_EPI) { if (wr == 0) PG8_BAR; }
    PG8_BAR;
    if constexpr (Epi::AFTER_DRAIN) { E.fused(acc, cur, wr, wc, fr, fq, lds, wid, lane); S.done(cur); }
#undef PG8_SA
#undef PG8_SB
#undef PG8_STAGE
#undef PG8_LDA
#undef PG8_LDB
#undef PG8_MMA
#undef PG8_WAIT_V
#undef PG8_WAIT_L
#undef PG8_BAR
#undef PG8_SCHED
}
}

#ifndef MK_N_LAUNCHES
#define MK_N_LAUNCHES 1
#endif
constexpr int DM = 1024, SEQ = 16384, NBATCH = 2, MP = NBATCH * SEQ, SBATCH = 32, STOK = 32, MS = SBATCH * STOK, MT = MP + MS;
constexpr int INW = 2560, DFF = 2816, PLE = 256, AW = 512, LW = 512, NHEAD = 8, HD = 64, KVL = 512, RELSZ = 192;
constexpr float EPS = 1e-6f;
constexpr float LOG2E = 1.4426950408889634f;
constexpr float QSCALE = 0.125f * LOG2E;
constexpr size_t OFF_Y = 0, OFF_NKP = (size_t)MT * DM, OFF_NVP = OFF_NKP + 524288, OFF_NCP = OFF_NVP + 524288, OFF_NHP = OFF_NCP + 3072,
                 OFF_NKS = OFF_NHP + 1024, OFF_NVS = OFF_NKS + 524288, OFF_NCS = OFF_NVS + 524288, OFF_NHS = OFF_NCS + 49152, OUT_TOTAL = OFF_NHS + 16384;
constexpr size_t al256(size_t x) { return (x + 255) & ~(size_t)255; }
constexpr size_t WS_WIN = 0;
constexpr size_t WS_WO  = WS_WIN + (size_t)INW * DM * 2;
constexpr size_t WS_WGU = WS_WO + (size_t)DM * DM * 2;
constexpr size_t WS_WD  = WS_WGU + (size_t)2 * DFF * DM * 2;
constexpr size_t WS_WPG = WS_WD + (size_t)DM * DFF * 2;
constexpr size_t WS_WPP = WS_WPG + (size_t)DM * DM * 2;
constexpr size_t WS_WRT = WS_WPP + (size_t)DM * PLE * 2;
constexpr size_t WS_WIT = WS_WRT + 8 * 64 * 64 * 2;
constexpr size_t WS_CTR = WS_WIT + 8 * 64 * 64 * 2;
constexpr size_t WS_BAR = WS_CTR + 4096;
constexpr size_t WS_AGG = WS_BAR + 16384;
constexpr size_t WS_SS1 = WS_AGG + (size_t)256 * 512 * 8;
constexpr size_t WS_SS2 = WS_SS1 + (size_t)MT * 16 * 4;
constexpr size_t WS_SSS2 = al256(WS_SS2 + (size_t)MT * 16 * 4);
constexpr size_t WS_XN  = al256(WS_SSS2 + (size_t)MS * 16 * 128);
constexpr size_t WS_PROJ = WS_XN + (size_t)MT * DM * 2;
constexpr size_t WS_VT  = WS_PROJ + (size_t)MT * DFF * 2;
constexpr size_t WS_KC  = WS_VT + (size_t)AW * MT * 2;
constexpr size_t WS_VTC = WS_KC + (size_t)SBATCH * KVL * AW * 2;
constexpr size_t WS_MIX = WS_VTC + (size_t)SBATCH * KVL * AW * 2;
constexpr size_t WS_Y12 = WS_MIX + (size_t)MT * DM * 2;
constexpr size_t WS_PB  = WS_Y12 + (size_t)MT * DM * 2;
constexpr size_t WS_END = WS_PB + (size_t)MT * PLE * 2;

constexpr int LDS_BYTES = 147456;

#define LAS __attribute__((address_space(3)))
typedef unsigned short bf16_t;
typedef short bf16x8 __attribute__((ext_vector_type(8)));
typedef float f32x4 __attribute__((ext_vector_type(4)));
typedef float f32x2 __attribute__((ext_vector_type(2)));
typedef unsigned u32x4 __attribute__((ext_vector_type(4)));
typedef unsigned u32x2 __attribute__((ext_vector_type(2)));
#define LDS_FENCE() asm volatile("s_waitcnt lgkmcnt(0)" ::: "memory")

typedef float f32x2_t __attribute__((ext_vector_type(2))); typedef __bf16 bf16x2_t __attribute__((ext_vector_type(2)));
__device__ __forceinline__ unsigned pk2(float lo, float hi) { const f32x2_t v = {lo, hi}; const bf16x2_t b = __builtin_convertvector(v, bf16x2_t); return __builtin_bit_cast(unsigned, b); }
__device__ __forceinline__ float bf2f(unsigned short b) { return __uint_as_float((unsigned)b << 16); }
__device__ __forceinline__ float wave_sum(float v) {
#pragma unroll
    for (int o = 1; o < 64; o <<= 1) v += __shfl_xor(v, o);
    return v;
}
__device__ __forceinline__ float fast_exp2(float x) { return __builtin_amdgcn_exp2f(x); }
__device__ __forceinline__ float fast_rcp(float x) { return __builtin_amdgcn_rcpf(x); }
__device__ __forceinline__ float sigmoid_f(float x) { return fast_rcp(1.f + fast_exp2(-x * LOG2E)); }

__device__ __forceinline__ float srow_rs(const float* sss, int r);
namespace pg8 {
struct EpiInProj {
    static constexpr bool PERM = true, AFTER_DRAIN = false;
    bf16_t* proj; bf16_t* vt; float* out; PG8_LAS unsigned char* stage;
    __device__ __forceinline__ void operator()(const f32x4 (&acc)[2][2][4][2], const Unit& u, int wr, int wc, int fr, int fq) const {
        const int pm = u.pm, pn = u.pn;
        const bool kvtail = (pm >= 128) || ((pm & 63) >= 62);
        const float sc = (pn < 2) ? QSCALE : 1.f;
#pragma unroll
        for (int ai = 0; ai < 2; ++ai)
#pragma unroll
            for (int m = 0; m < 4; ++m) {
                const int row = pm * BM + ai * HALF + wr * 64 + m * 16 + fr;
#pragma unroll
                for (int bj = 0; bj < 2; ++bj) {
                    const int col = pn * BM + bj * HALF + wc * 32 + 8 * fq;
                    const f32x4 v0 = acc[ai][bj][m][0] * sc, v1 = acc[ai][bj][m][1] * sc;
                    if (pn == 4 || pn == 5) {
                        PG8_LAS bf16_t* stg = (PG8_LAS bf16_t*)(stage + ((wr * 4 + wc) << 10));
                        const int lc = 8 * fq;
#pragma unroll
                        for (int i = 0; i < 4; ++i) { stg[(lc + i) * 16 + fr] = (bf16_t)(pk2(v0[i], 0.f) & 0xffffu); stg[(lc + 4 + i) * 16 + fr] = (bf16_t)(pk2(v1[i], 0.f) & 0xffffu); }
                        asm volatile("s_waitcnt lgkmcnt(0)" ::: "memory");
                        const int ln = fq * 16 + fr, c2 = ln >> 1, hf = ln & 1;
                        const u32x4 w = *(const PG8_LAS u32x4*)(stg + c2 * 16 + 8 * hf);
                        asm volatile("s_waitcnt lgkmcnt(0)" ::: "memory");
                        const int hd0 = pn * BM + bj * HALF + wc * 32 - 1024, rowb = pm * BM + ai * HALF + wr * 64 + m * 16;
                        *(u32x4*)(vt + (size_t)(hd0 + c2) * MT + rowb + 8 * hf) = w;
                    } else {
                        u32x4 w; w.x = pk2(v0[0], v0[1]); w.y = pk2(v0[2], v0[3]); w.z = pk2(v1[0], v1[1]); w.w = pk2(v1[2], v1[3]);
                        *(u32x4*)(proj + (size_t)row * INW + col) = w;
                    }
                    if (pn >= 2 && pn <= 5 && kvtail) {
                        const int c = col - (pn < 4 ? 512 : 1024);
                        float* dst;
                        if (row < MP) { const int b = row >> 14, s = row & (SEQ - 1); dst = out + (pn < 4 ? OFF_NKP : OFF_NVP) + (size_t)(b * 512 + (s - (SEQ - 512))) * 512 + c; }
                        else dst = out + (pn < 4 ? OFF_NKS : OFF_NVS) + (size_t)(row - MP) * 512 + c;
                        *(f32x4*)dst = v0; *(f32x4*)(dst + 4) = v1;
                    }
                    if (pn == 6 || pn == 7) {
                        const int c = col - 1536;
                        if (row < MP) { const int s = row & (SEQ - 1); if (s >= SEQ - 3) { float* dst = out + OFF_NCP + (size_t)((row >> 14) * 3 + (s - (SEQ - 3))) * 512 + c; *(f32x4*)dst = v0; *(f32x4*)(dst + 4) = v1; } }
                        else { const int t = (row - MP) & 31; if (t >= 29) { float* dst = out + OFF_NCS + (size_t)(((row - MP) >> 5) * 3 + (t - 29)) * 512 + c; *(f32x4*)dst = v0; *(f32x4*)(dst + 4) = v1; } }
                    }
                }
            }
    }
};
template <bool F32BASE> struct EpiResid {
    static constexpr bool PERM = true, AFTER_DRAIN = false;
    const float* base_p; const float* base_s; bf16_t* hb; float* ss;
    __device__ __forceinline__ void operator()(const f32x4 (&acc)[2][2][4][2], const Unit& u, int wr, int wc, int fr, int fq) const {
        const int col0 = u.pn * BM + wc * 32 + 8 * fq;
#pragma unroll
        for (int ai = 0; ai < 2; ++ai)
#pragma unroll
            for (int m = 0; m < 4; ++m) {
                const int r = u.pm * BM + ai * HALF + wr * 64 + m * 16 + fr;
                float s = 0.f;
#pragma unroll
                for (int bj = 0; bj < 2; ++bj) {
                    const int c = col0 + bj * HALF;
                    f32x4 v0, v1;
                    if (F32BASE) { const float* brow = (r < MP) ? base_p + (size_t)r * DM : base_s + (size_t)(r - MP) * DM; v0 = *(const f32x4*)(brow + c); v1 = *(const f32x4*)(brow + c + 4); }
                    else { const u32x4 w = *(const u32x4*)(hb + (size_t)r * DM + c);
                        v0 = (f32x4){__uint_as_float(w.x << 16), __uint_as_float(w.x & 0xffff0000u), __uint_as_float(w.y << 16), __uint_as_float(w.y & 0xffff0000u)};
                        v1 = (f32x4){__uint_as_float(w.z << 16), __uint_as_float(w.z & 0xffff0000u), __uint_as_float(w.w << 16), __uint_as_float(w.w & 0xffff0000u)}; }
                    v0 = v0 + acc[ai][bj][m][0]; v1 = v1 + acc[ai][bj][m][1];
                    s += ((v0[0] * v0[0] + v0[1] * v0[1]) + (v0[2] * v0[2] + v0[3] * v0[3])) + ((v1[0] * v1[0] + v1[1] * v1[1]) + (v1[2] * v1[2] + v1[3] * v1[3]));
                    u32x4 o; o.x = pk2(v0[0], v0[1]); o.y = pk2(v0[2], v0[3]); o.z = pk2(v1[0], v1[1]); o.w = pk2(v1[2], v1[3]);
                    *(u32x4*)(hb + (size_t)r * DM + c) = o;
                }
                s += __shfl_xor(s, 16); s += __shfl_xor(s, 32);
                if (fq == 0) ss[(size_t)r * 16 + u.pn * 4 + wc] = s;
            }
    }
};
__device__ __forceinline__ float row_rs(const float* ss, int r) {
    const f32x4* p = (const f32x4*)(ss + (size_t)r * 16);
    const f32x4 a = p[0], b = p[1], c = p[2], d = p[3];
    const float t = ((a[0] + a[1]) + (a[2] + a[3])) + ((b[0] + b[1]) + (b[2] + b[3])) + ((c[0] + c[1]) + (c[2] + c[3])) + ((d[0] + d[1]) + (d[2] + d[3]));
    return __builtin_amdgcn_rsqf(t * (1.f / DM) + EPS);
}
struct EpiSwiglu {
    static constexpr bool PERM = true, AFTER_DRAIN = false;
    const float* ss; bf16_t* act;
    __device__ __forceinline__ void operator()(const f32x4 (&acc)[2][2][4][2], const Unit& u, int wr, int wc, int fr, int fq) const {
        const int f0 = u.pn * HALF + wc * 32 + 8 * fq;
#pragma unroll
        for (int ai = 0; ai < 2; ++ai)
#pragma unroll
            for (int m = 0; m < 4; ++m) {
                const int r = u.pm * BM + ai * HALF + wr * 64 + m * 16 + fr;
                const float rs = row_rs(ss, r);
                float o[8];
#pragma unroll
                for (int n = 0; n < 2; ++n)
#pragma unroll
                    for (int i = 0; i < 4; ++i) { const float g = acc[ai][0][m][n][i] * rs, up = acc[ai][1][m][n][i] * rs; o[n * 4 + i] = g * sigmoid_f(g) * up; }
                u32x4 w; w.x = pk2(o[0], o[1]); w.y = pk2(o[2], o[3]); w.z = pk2(o[4], o[5]); w.w = pk2(o[6], o[7]);
                *(u32x4*)(act + (size_t)r * DFF + f0) = w;
            }
    }
};
struct EpiStoreBf16 {
    static constexpr bool PERM = true, AFTER_DRAIN = false;
    bf16_t* o;
    __device__ __forceinline__ void operator()(const f32x4 (&acc)[2][2][4][2], const Unit& u, int wr, int wc, int fr, int fq) const {
#pragma unroll
        for (int ai = 0; ai < 2; ++ai)
#pragma unroll
            for (int m = 0; m < 4; ++m) {
                const int r = u.pm * BM + ai * HALF + wr * 64 + m * 16 + fr;
#pragma unroll
                for (int bj = 0; bj < 2; ++bj) {
                    const int c = u.pn * BM + bj * HALF + wc * 32 + 8 * fq;
                    const f32x4 v0 = acc[ai][bj][m][0], v1 = acc[ai][bj][m][1];
                    u32x4 w; w.x = pk2(v0[0], v0[1]); w.y = pk2(v0[2], v0[3]); w.z = pk2(v1[0], v1[1]); w.w = pk2(v1[2], v1[3]);
                    *(u32x4*)(o + (size_t)r * DM + c) = w;
                }
            }
    }
};
struct EpiPleGate {
    static constexpr bool PERM = true, AFTER_DRAIN = false;
    const float* ss; const float* sss; const bf16_t* pp; const bf16_t* h2; bf16_t* h3;
    __device__ __forceinline__ void operator()(const f32x4 (&acc)[2][2][4][2], const Unit& u, int wr, int wc, int fr, int fq) const {
        const int col0 = u.pn * BM + wc * 32 + 8 * fq;
#pragma unroll
        for (int ai = 0; ai < 2; ++ai)
#pragma unroll
            for (int m = 0; m < 4; ++m) {
                const int r = u.pm * BM + ai * HALF + wr * 64 + m * 16 + fr;
                float rs; if (u.pm < MP / BM) rs = row_rs(ss, r); else rs = srow_rs(sss, r);
#pragma unroll
                for (int bj = 0; bj < 2; ++bj) {
                    const int c = col0 + bj * HALF;
                    const u32x4 pw = *(const u32x4*)(pp + (size_t)r * DM + c), hw = *(const u32x4*)(h2 + (size_t)r * DM + c);
                    const f32x4 a0 = acc[ai][bj][m][0], a1 = acc[ai][bj][m][1];
                    float o[8];
                    o[0] = __uint_as_float(hw.x << 16) + __uint_as_float(pw.x << 16) * sigmoid_f(a0[0] * rs); o[1] = __uint_as_float(hw.x & 0xffff0000u) + __uint_as_float(pw.x & 0xffff0000u) * sigmoid_f(a0[1] * rs);
                    o[2] = __uint_as_float(hw.y << 16) + __uint_as_float(pw.y << 16) * sigmoid_f(a0[2] * rs); o[3] = __uint_as_float(hw.y & 0xffff0000u) + __uint_as_float(pw.y & 0xffff0000u) * sigmoid_f(a0[3] * rs);
                    o[4] = __uint_as_float(hw.z << 16) + __uint_as_float(pw.z << 16) * sigmoid_f(a1[0] * rs); o[5] = __uint_as_float(hw.z & 0xffff0000u) + __uint_as_float(pw.z & 0xffff0000u) * sigmoid_f(a1[1] * rs);
                    o[6] = __uint_as_float(hw.w << 16) + __uint_as_float(pw.w << 16) * sigmoid_f(a1[2] * rs); o[7] = __uint_as_float(hw.w & 0xffff0000u) + __uint_as_float(pw.w & 0xffff0000u) * sigmoid_f(a1[3] * rs);
                    u32x4 w; w.x = pk2(o[0], o[1]); w.y = pk2(o[2], o[3]); w.z = pk2(o[4], o[5]); w.w = pk2(o[6], o[7]);
                    *(u32x4*)(h3 + (size_t)r * DM + c) = w;
                }
            }
    }
};
}

struct Params { const float* in[29]; float* out; unsigned char* ws; int ph_lo, ph_hi; };
enum { I_XP = 0, I_XS, I_PP, I_PS, I_CK, I_CV, I_SCONV, I_SH, I_GMIX, I_WIN, I_CONVW, I_CONVB, I_WR, I_BR, I_WI, I_BI, I_LAMBDA, I_REL, I_GATT, I_GLRU, I_WOUT, I_GFFN,
       I_WG, I_WU, I_WD, I_GPLE, I_WPG, I_WPP, I_GFINAL };

__device__ __forceinline__ void p0_transpose_item(const float* W, int N, bf16_t* WT, int ldk, int drow0, const float* g, LAS float* scr, int k0, int n0, int lane) {
#pragma unroll 8
    for (int i = 0; i < 32; ++i) { const int kk = 2 * i + (lane >> 5); float v = W[(size_t)(k0 + kk) * N + n0 + (lane & 31)]; if (g) v *= g[k0 + kk]; scr[kk * 33 + (lane & 31)] = v; }
    LDS_FENCE();
    const int c = lane & 7;
#pragma unroll
    for (int j = 0; j < 4; ++j) { const int n = (lane >> 3) + 8 * j; const LAS float* s = scr + (8 * c) * 33 + n;
        u32x4 o; o.x = pk2(s[0 * 33], s[1 * 33]); o.y = pk2(s[2 * 33], s[3 * 33]); o.z = pk2(s[4 * 33], s[5 * 33]); o.w = pk2(s[6 * 33], s[7 * 33]);
        *(u32x4*)(WT + (size_t)(drow0 + n) * ldk + k0 + 8 * c) = o; }
    LDS_FENCE();
}

__device__ __forceinline__ void p0_prologue(const Params& p, LAS unsigned char* lds, int wave, int lane, int part, int gw, int NGW) {
    unsigned char* ws = p.ws;
    LAS float* scr = (LAS float*)(lds + wave * 16384);
    constexpr int T_WIN = 16 * 80, T_WO = 16 * 32, T_WG = 16 * 88, T_WU = T_WG, T_WD = 44 * 32, T_WPG = 16 * 32, T_WPP = 4 * 32, T_GR = 8 * 2, T_GI = 8 * 2, T_CV = 32 * 8 * 16;
    constexpr int NT = T_WIN + T_WO + T_WG + T_WU + T_WD + T_WPG + T_WPP + T_GR + T_GI + T_CV;
    constexpr int D_LO = T_WIN + T_WO, D_HI = D_LO + T_WG + T_WU + T_WD + T_WPG;
    const int n_it = part ? (D_HI - D_LO) : NT - (D_HI - D_LO);
    for (int ii = gw; ii < n_it; ii += NGW) {
        const int it = part ? D_LO + ii : (ii < D_LO ? ii : ii + (D_HI - D_LO));
        int r = it;
        if (r < T_WIN) { p0_transpose_item(p.in[I_WIN], INW, (bf16_t*)(ws + WS_WIN), DM, (r % 80) * 32, nullptr, scr, (r / 80) * 64, (r % 80) * 32, lane); continue; } r -= T_WIN;
        if (r < T_WO)  { p0_transpose_item(p.in[I_WOUT], DM, (bf16_t*)(ws + WS_WO), DM, (r % 32) * 32, nullptr, scr, (r / 32) * 64, (r % 32) * 32, lane); continue; } r -= T_WO;
        if (r < T_WG)  { const int n0 = (r % 88) * 32; p0_transpose_item(p.in[I_WG], DFF, (bf16_t*)(ws + WS_WGU), DM, 256 * (n0 / 128) + (n0 % 128), p.in[I_GFFN], scr, (r / 88) * 64, n0, lane); continue; } r -= T_WG;
        if (r < T_WU)  { const int n0 = (r % 88) * 32; p0_transpose_item(p.in[I_WU], DFF, (bf16_t*)(ws + WS_WGU), DM, 256 * (n0 / 128) + 128 + (n0 % 128), p.in[I_GFFN], scr, (r / 88) * 64, n0, lane); continue; } r -= T_WU;
        if (r < T_WD)  { p0_transpose_item(p.in[I_WD], DM, (bf16_t*)(ws + WS_WD), DFF, (r % 32) * 32, nullptr, scr, (r / 32) * 64, (r % 32) * 32, lane); continue; } r -= T_WD;
        if (r < T_WPG) { p0_transpose_item(p.in[I_WPG], DM, (bf16_t*)(ws + WS_WPG), DM, (r % 32) * 32, p.in[I_GPLE], scr, (r / 32) * 64, (r % 32) * 32, lane); continue; } r -= T_WPG;
        if (r < T_WPP) { p0_transpose_item(p.in[I_WPP], DM, (bf16_t*)(ws + WS_WPP), PLE, (r % 32) * 32, nullptr, scr, (r / 32) * 64, (r % 32) * 32, lane); continue; } r -= T_WPP;
        if (r < T_GR)  { const int n = r >> 1; p0_transpose_item(p.in[I_WR] + n * 4096, 64, (bf16_t*)(ws + WS_WRT) + n * 4096, 64, (r & 1) * 32, nullptr, scr, 0, (r & 1) * 32, lane); continue; } r -= T_GR;
        if (r < T_GI)  { const int n = r >> 1; p0_transpose_item(p.in[I_WI] + n * 4096, 64, (bf16_t*)(ws + WS_WIT) + n * 4096, 64, (r & 1) * 32, nullptr, scr, 0, (r & 1) * 32, lane); continue; } r -= T_GI;
        { const int b = r >> 7, q = r & 127; p0_transpose_item(p.in[I_CV] + (size_t)b * KVL * AW, AW, (bf16_t*)(ws + WS_VTC) + (size_t)b * AW * KVL, KVL, (q & 15) * 32, nullptr, scr, (q >> 4) * 64, (q & 15) * 32, lane); }
    }
    if (part) return;
    bf16_t* XN = (bf16_t*)(ws + WS_XN); bf16_t* PB = (bf16_t*)(ws + WS_PB);
    const f32x4* gm = (const f32x4*)p.in[I_GMIX];
    for (int m = gw; m < MT; m += NGW) {
        const float* xrow = (m < MP) ? p.in[I_XP] + (size_t)m * DM : p.in[I_XS] + (size_t)(m - MP) * DM;
        const f32x4* xr = (const f32x4*)xrow + lane;
        f32x4 v[4]; float s = 0.f;
#pragma unroll
        for (int j = 0; j < 4; ++j) { v[j] = xr[64 * j]; s += (v[j][0] * v[j][0] + v[j][1] * v[j][1]) + (v[j][2] * v[j][2] + v[j][3] * v[j][3]); }
        const float rs = __builtin_amdgcn_rsqf(wave_sum(s) * (1.f / DM) + EPS);
        u32x2* o8 = (u32x2*)(XN + (size_t)m * DM) + lane;
#pragma unroll
        for (int j = 0; j < 4; ++j) { const f32x4 g = gm[lane + 64 * j]; u32x2 w; w.x = pk2(v[j][0] * rs * g[0], v[j][1] * rs * g[1]); w.y = pk2(v[j][2] * rs * g[2], v[j][3] * rs * g[3]); o8[64 * j] = w; }
        const float* prow = (m < MP) ? p.in[I_PP] + (size_t)m * PLE : p.in[I_PS] + (size_t)(m - MP) * PLE;
        const f32x4 pv = ((const f32x4*)prow)[lane];
        u32x2 w; w.x = pk2(pv[0], pv[1]); w.y = pk2(pv[2], pv[3]);
        ((u32x2*)(PB + (size_t)m * PLE))[lane] = w;
    }
    bf16_t* KC = (bf16_t*)(ws + WS_KC);
    constexpr int NKC = SBATCH * KVL * AW / 512;
    for (int it = gw; it < NKC; it += NGW) {
        const f32x4* src = (const f32x4*)(p.in[I_CK] + (size_t)it * 512) + 2 * lane;
        const f32x4 a = src[0], b = src[1];
        u32x4 w; w.x = pk2(a[0], a[1]); w.y = pk2(a[2], a[3]); w.z = pk2(b[0], b[1]); w.w = pk2(b[2], b[3]);
        ((u32x4*)(KC + (size_t)it * 512))[lane] = w;
    }
}

template <int MQ>
__device__ __forceinline__ void attn_item(const Params& p, LAS unsigned char* lds, int wave, int lane, bool sample, int ib, int ic) {
    unsigned char* ws = p.ws;
    const bf16_t* proj = (const bf16_t*)(ws + WS_PROJ); const bf16_t* vt = (const bf16_t*)(ws + WS_VT);
    const bf16_t* kc = (const bf16_t*)(ws + WS_KC); const bf16_t* vtc = (const bf16_t*)(ws + WS_VTC);
    bf16_t* mix = (bf16_t*)(ws + WS_MIX);
    LAS float* tab = (LAS float*)lds;
    LAS float* ssq = (LAS float*)(lds + 8192);
    const int fr = lane & 15, fq = lane >> 4, h = wave;
    const int qrow0 = sample ? MP + STOK * ib : ib * SEQ + 64 * ic;
    bf16x8 qf[MQ][2];
    { const bf16_t* qp = proj + (size_t)(qrow0 + fr) * INW + h * HD + 8 * fq;
#pragma unroll
      for (int qt = 0; qt < MQ; ++qt)
#pragma unroll
          for (int ks = 0; ks < 2; ++ks) qf[qt][ks] = *(const bf16x8*)(qp + (size_t)qt * 16 * INW + 32 * ks); }
    f32x4 o[4][MQ];
    float mref[MQ], lsum[MQ];
#pragma unroll
    for (int qt = 0; qt < MQ; ++qt) { mref[qt] = -1e30f; lsum[qt] = 0.f;
#pragma unroll
        for (int dt = 0; dt < 4; ++dt) o[dt][qt] = (f32x4){0.f, 0.f, 0.f, 0.f}; }
    const int kperm = 8 * (fr >> 2) + (fr & 3);
    const bool uni = !sample && ic < 8;
    const int t0 = sample ? 0 : (ic < 8 ? 2 * (8 - ic) : (ic < 16 ? 2 * (16 - ic) : 0)), nt = sample ? 17 : 18;
    const LAS float* tb = tab + h * RELSZ;
#define ATT_TILE_PTRS(T, KP, KST, VP, VST, KPOS0) do { \
        if (sample && (T) < 16) { KP = kc + ((size_t)(ib * KVL + 32 * (T))) * AW + h * HD; KST = AW; VP = vtc + ((size_t)(ib * AW + h * HD)) * KVL + 32 * (T); VST = KVL; KPOS0 = -KVL + 32 * (T); } \
        else { int krow0_; if (sample) { krow0_ = qrow0; KPOS0 = 0; } else { const int dl_ = -8 + ((T) >> 1); krow0_ = ib * SEQ + 64 * (ic + dl_) + 32 * ((T) & 1); KPOS0 = 64 * dl_ + 32 * ((T) & 1); } \
            KP = proj + (size_t)krow0_ * INW + 512 + h * HD; KST = INW; VP = vt + (size_t)(h * HD) * MT + krow0_; VST = MT; } } while (0)
    bf16x8 kf[2][2];
    { const bf16_t* kp; const bf16_t* vp; size_t kst, vst; int kpos0; ATT_TILE_PTRS(t0, kp, kst, vp, vst, kpos0); (void)vp; (void)vst; (void)kpos0;
#pragma unroll
      for (int kt = 0; kt < 2; ++kt)
#pragma unroll
          for (int ks = 0; ks < 2; ++ks) kf[kt][ks] = *(const bf16x8*)(kp + (size_t)(kperm + 4 * kt) * kst + 32 * ks + 8 * fq); }
    for (int t = t0; t < nt; ++t) {
        const bf16_t* kp; const bf16_t* vp; size_t kst, vst; int kpos0;
        ATT_TILE_PTRS(t, kp, kst, vp, vst, kpos0);
        bf16x8 vf[4], kn[2][2];
#pragma unroll
        for (int dt = 0; dt < 4; ++dt) vf[dt] = *(const bf16x8*)(vp + (size_t)(dt * 16 + fr) * vst + 8 * fq);
        { const int tn = (t + 1 < nt) ? t + 1 : t; const bf16_t* kp2; const bf16_t* vp2; size_t kst2, vst2; int kpos2; ATT_TILE_PTRS(tn, kp2, kst2, vp2, vst2, kpos2); (void)vp2; (void)vst2; (void)kpos2;
#pragma unroll
          for (int kt = 0; kt < 2; ++kt)
#pragma unroll
              for (int ks = 0; ks < 2; ++ks) kn[kt][ks] = *(const bf16x8*)(kp2 + (size_t)(kperm + 4 * kt) * kst2 + 32 * ks + 8 * fq); }
        (void)kp; (void)kst;
        bf16x8 pf[MQ];
        if (uni) {
#pragma unroll
            for (int qt = 0; qt < MQ; ++qt) pf[qt] = __builtin_bit_cast(bf16x8, (u32x4){0x3F803F80u, 0x3F803F80u, 0x3F803F80u, 0x3F803F80u});
        } else {
        f32x4 s[2][MQ];
#pragma unroll
        for (int kt = 0; kt < 2; ++kt)
#pragma unroll
            for (int qt = 0; qt < MQ; ++qt) {
                s[kt][qt] = __builtin_amdgcn_mfma_f32_16x16x32_bf16(kf[kt][0], qf[qt][0], (f32x4){0.f, 0.f, 0.f, 0.f}, 0, 0, 0);
                s[kt][qt] = __builtin_amdgcn_mfma_f32_16x16x32_bf16(kf[kt][1], qf[qt][1], s[kt][qt], 0, 0, 0);
            }
        if (kpos0 <= -160) {
            const float b0 = tb[0];
#pragma unroll
            for (int kt = 0; kt < 2; ++kt)
#pragma unroll
                for (int qt = 0; qt < MQ; ++qt) s[kt][qt] = s[kt][qt] + b0;
        } else {
#pragma unroll
            for (int kt = 0; kt < 2; ++kt)
#pragma unroll
                for (int qt = 0; qt < MQ; ++qt)
#pragma unroll
                    for (int i = 0; i < 4; ++i) {
                        int rel = kpos0 + 8 * fq + 4 * kt + i - (qt * 16 + fr);
                        rel = rel < -128 ? -128 : (rel > 63 ? 63 : rel);
                        s[kt][qt][i] += tb[rel + 128];
                    }
        }
        bool need = false; float lm[MQ];
#pragma unroll
        for (int qt = 0; qt < MQ; ++qt) {
            float a = fmaxf(fmaxf(s[0][qt][0], s[0][qt][1]), fmaxf(s[0][qt][2], s[0][qt][3]));
            float b = fmaxf(fmaxf(s[1][qt][0], s[1][qt][1]), fmaxf(s[1][qt][2], s[1][qt][3]));
            lm[qt] = fmaxf(a, b); need = need || (lm[qt] > mref[qt] + 8.f);
        }
        if (__any(need)) {
#pragma unroll
            for (int qt = 0; qt < MQ; ++qt) {
                float rm = lm[qt]; rm = fmaxf(rm, __shfl_xor(rm, 16)); rm = fmaxf(rm, __shfl_xor(rm, 32));
                const float mn = fmaxf(mref[qt], rm), al = fast_exp2(mref[qt] - mn);
                mref[qt] = mn; lsum[qt] *= al;
#pragma unroll
                for (int dt = 0; dt < 4; ++dt) o[dt][qt] = o[dt][qt] * al;
            }
        }
#pragma unroll
        for (int qt = 0; qt < MQ; ++qt) {
            float e[8];
#pragma unroll
            for (int i = 0; i < 4; ++i) { e[i] = fast_exp2(s[0][qt][i] - mref[qt]); e[4 + i] = fast_exp2(s[1][qt][i] - mref[qt]); }
            lsum[qt] += ((e[0] + e[1]) + (e[2] + e[3])) + ((e[4] + e[5]) + (e[6] + e[7]));
            u32x4 w; w.x = pk2(e[0], e[1]); w.y = pk2(e[2], e[3]); w.z = pk2(e[4], e[5]); w.w = pk2(e[6], e[7]);
            pf[qt] = __builtin_bit_cast(bf16x8, w);
        }
        }
#pragma unroll
        for (int dt = 0; dt < 4; ++dt)
#pragma unroll
            for (int qt = 0; qt < MQ; ++qt) o[dt][qt] = __builtin_amdgcn_mfma_f32_16x16x32_bf16(vf[dt], pf[qt], o[dt][qt], 0, 0, 0);
#pragma unroll
        for (int kt = 0; kt < 2; ++kt)
#pragma unroll
            for (int ks = 0; ks < 2; ++ks) kf[kt][ks] = kn[kt][ks];
    }
#undef ATT_TILE_PTRS
#pragma unroll
    for (int qt = 0; qt < MQ; ++qt) {
        float l = lsum[qt]; l += __shfl_xor(l, 16); l += __shfl_xor(l, 32);
        const float inv = uni ? (1.f / 576.f) : 1.f / l; float sq = 0.f;
#pragma unroll
        for (int dt = 0; dt < 4; ++dt) { o[dt][qt] = o[dt][qt] * inv; const f32x4 v = o[dt][qt]; sq += (v[0] * v[0] + v[1] * v[1]) + (v[2] * v[2] + v[3] * v[3]); }
        sq += __shfl_xor(sq, 16); sq += __shfl_xor(sq, 32);
        if (fq == 0) ssq[h * 64 + qt * 16 + fr] = sq;
    }
    __syncthreads();
    const float* ga = p.in[I_GATT] + h * HD + 4 * fq;
#pragma unroll
    for (int qt = 0; qt < MQ; ++qt) {
        float tot = 0.f;
#pragma unroll
        for (int hh = 0; hh < 8; ++hh) tot += ssq[hh * 64 + qt * 16 + fr];
        const float rs = __builtin_amdgcn_rsqf(tot * (1.f / AW) + EPS);
        bf16_t* mp = mix + (size_t)(qrow0 + qt * 16 + fr) * DM + h * HD + 4 * fq;
#pragma unroll
        for (int dt = 0; dt < 4; ++dt) {
            const f32x4 g = *(const f32x4*)(ga + dt * 16); const f32x4 v = o[dt][qt] * rs;
            u32x2 w; w.x = pk2(v[0] * g[0], v[1] * g[1]); w.y = pk2(v[2] * g[2], v[3] * g[3]);
            *(u32x2*)(mp + dt * 16) = w;
        }
    }
    __syncthreads();
}

__device__ __forceinline__ float gelu_tanh(float x) { const float z = 0.7978845608028654f * (x + 0.044715f * x * x * x); return x * fast_rcp(1.f + fast_exp2(-2.f * LOG2E * z)); }
__device__ __forceinline__ void lru_item(const Params& p, LAS unsigned char* lds, int wave, int lane, int tile) {
    unsigned char* ws = p.ws;
    const bf16_t* proj = (const bf16_t*)(ws + WS_PROJ);
    bf16_t* Y1 = (bf16_t*)(ws + WS_Y12); bf16_t* Y2 = Y1 + (size_t)MT * LW;
    LAS bf16_t* xcs = (LAS bf16_t*)(lds + 16384 + wave * 12288);
    LAS f32x2* ag = (LAS f32x2*)(lds + 16384 + wave * 12288 + 4096);
    const int fr = lane & 15, fq = lane >> 4, n = wave, c = n * 64 + lane;
    const bool sample = tile >= 128;
    const int row0 = sample ? MP + STOK * (tile - 128) : tile * 256;
    const int nsub = sample ? 2 : 16;
    bf16x8 wrf[4][2], wif[4][2];
    { const bf16_t* wr = (const bf16_t*)(ws + WS_WRT) + n * 4096; const bf16_t* wi = (const bf16_t*)(ws + WS_WIT) + n * 4096;
#pragma unroll
      for (int jt = 0; jt < 4; ++jt)
#pragma unroll
          for (int ks = 0; ks < 2; ++ks) { wrf[jt][ks] = *(const bf16x8*)(wr + (jt * 16 + fr) * 64 + 32 * ks + 8 * fq); wif[jt][ks] = *(const bf16x8*)(wi + (jt * 16 + fr) * 64 + 32 * ks + 8 * fq); } }
    float br[4], bi[4], sp8[4];
#pragma unroll
    for (int jt = 0; jt < 4; ++jt) { const int ch = n * 64 + jt * 16 + fr; br[jt] = p.in[I_BR][ch]; bi[jt] = p.in[I_BI][ch];
        const float L = p.in[I_LAMBDA][ch]; sp8[jt] = 8.f * LOG2E * (fmaxf(-L, 0.f) + log1pf(__expf(-fabsf(L)))); }
    const float cw0 = p.in[I_CONVW][c], cw1 = p.in[I_CONVW][512 + c], cw2 = p.in[I_CONVW][1024 + c], cw3 = p.in[I_CONVW][1536 + c], cb = p.in[I_CONVB][c];
    float xm3, xm2, xm1, h, P = 1.f;
    if (sample) { const float* sc = p.in[I_SCONV] + (size_t)(tile - 128) * 3 * LW + c; xm3 = sc[0]; xm2 = sc[LW]; xm1 = sc[2 * LW]; h = p.in[I_SH][(tile - 128) * LW + c]; }
    else if ((tile & 63) == 0) { xm3 = xm2 = xm1 = 0.f; h = 0.f; }
    else { const bf16_t* xp = proj + (size_t)(row0 - 3) * INW + 1536 + c; xm3 = bf2f(xp[0]); xm2 = bf2f(xp[INW]); xm1 = bf2f(xp[2 * INW]); h = 0.f; }
    bf16_t xr_[16], gr_[16];
    { const bf16_t* xp = proj + (size_t)row0 * INW + 1536 + c;
#pragma unroll
      for (int t = 0; t < 16; ++t) { xr_[t] = xp[(size_t)t * INW]; gr_[t] = xp[(size_t)t * INW + 512]; } }
    for (int sub = 0; sub < nsub; ++sub) {
        const int r0 = row0 + sub * 16;
        bf16_t xn_[16], gn_[16];
        { const bf16_t* xp = proj + (size_t)(row0 + (sub + 1 < nsub ? sub + 1 : sub) * 16) * INW + 1536 + c;
#pragma unroll
          for (int t = 0; t < 16; ++t) { xn_[t] = xp[(size_t)t * INW]; gn_[t] = xp[(size_t)t * INW + 512]; } }
        float xc[16], ge[16];
#pragma unroll
        for (int t = 0; t < 16; ++t) { const float xv = bf2f(xr_[t]); ge[t] = gelu_tanh(bf2f(gr_[t]));
            xc[t] = cb + cw0 * xm3 + cw1 * xm2 + cw2 * xm1 + cw3 * xv; xm3 = xm2; xm2 = xm1; xm1 = xv;
            xcs[t * 72 + lane] = (bf16_t)(pk2(xc[t], 0.f) & 0xffffu); }
#pragma unroll
        for (int t = 0; t < 16; ++t) { xr_[t] = xn_[t]; gr_[t] = gn_[t]; }
        LDS_FENCE();
        bf16x8 xa[2];
#pragma unroll
        for (int ks = 0; ks < 2; ++ks) xa[ks] = *(const LAS bf16x8*)(xcs + fr * 72 + 32 * ks + 8 * fq);
#pragma unroll
        for (int jt = 0; jt < 4; ++jt) {
            f32x4 pr = __builtin_amdgcn_mfma_f32_16x16x32_bf16(xa[0], wrf[jt][0], (f32x4){0.f, 0.f, 0.f, 0.f}, 0, 0, 0);
            pr = __builtin_amdgcn_mfma_f32_16x16x32_bf16(xa[1], wrf[jt][1], pr, 0, 0, 0);
            f32x4 pi = __builtin_amdgcn_mfma_f32_16x16x32_bf16(xa[0], wif[jt][0], (f32x4){0.f, 0.f, 0.f, 0.f}, 0, 0, 0);
            pi = __builtin_amdgcn_mfma_f32_16x16x32_bf16(xa[1], wif[jt][1], pi, 0, 0, 0);
#pragma unroll
            for (int i = 0; i < 4; ++i) {
                const float r = sigmoid_f(pr[i] + br[jt]), ig = sigmoid_f(pi[i] + bi[jt]);
                const float a = fast_exp2(-r * sp8[jt]), mlt = __builtin_amdgcn_sqrtf(fmaxf(1.f - a * a, 0.f)) * ig;
                ag[(4 * fq + i) * 64 + jt * 16 + fr] = (f32x2){a, mlt};
            }
        }
        LDS_FENCE();
        bf16_t* y1p = Y1 + (size_t)r0 * LW + c; bf16_t* y2p = Y2 + (size_t)r0 * LW + c;
#pragma unroll
        for (int t = 0; t < 16; ++t) {
            const f32x2 am = ag[t * 64 + lane];
            h = am.x * h + am.y * xc[t]; P *= am.x;
            y1p[(size_t)t * LW] = (bf16_t)(pk2(h * ge[t], 0.f) & 0xffffu);
            y2p[(size_t)t * LW] = (bf16_t)(pk2(P * ge[t], 0.f) & 0xffffu);
        }
        LDS_FENCE();
    }
    if (sample) p.out[OFF_NHS + (size_t)(tile - 128) * LW + c] = h;
    else ((f32x2*)(ws + WS_AGG))[(size_t)tile * LW + c] = (f32x2){P, h};
}

__device__ __forceinline__ void fixup_item(const Params& p, LAS unsigned char* lds, int wave, int lane, int it) {
    unsigned char* ws = p.ws;
    const bf16_t* Y1 = (const bf16_t*)(ws + WS_Y12); const bf16_t* Y2 = Y1 + (size_t)MT * LW;
    bf16_t* mix = (bf16_t*)(ws + WS_MIX);
    LAS float* carry = (LAS float*)lds;
    const int tid = wave * 64 + lane;
    int row0;
    if (it < 256) {
        const int tile = it >> 1; row0 = it * 128;
        const f32x2* agg = (const f32x2*)(ws + WS_AGG);
        float cv = 0.f;
        for (int j0 = tile & ~63; j0 < tile; j0 += 32) {
            f32x2 au[32];
#pragma unroll
            for (int u = 0; u < 32; ++u) { const int j = (j0 + u < tile) ? j0 + u : tile - 1; au[u] = agg[(size_t)j * LW + tid]; }
#pragma unroll
            for (int u = 0; u < 32; ++u) if (j0 + u < tile) cv = au[u].x * cv + au[u].y;
        }
        carry[tid] = cv;
        if ((tile & 63) == 63 && (it & 1)) { const f32x2 au = agg[(size_t)tile * LW + tid]; p.out[OFF_NHP + (tile >> 6) * LW + tid] = au.x * cv + au.y; }
    } else { row0 = MP + (it - 256) * 128; carry[tid] = 0.f; }
    __syncthreads();
    f32x4 c0 = *(const LAS f32x4*)(carry + 8 * lane), c1 = *(const LAS f32x4*)(carry + 8 * lane + 4);
    const f32x4 g0 = *(const f32x4*)(p.in[I_GLRU] + 8 * lane), g1 = *(const f32x4*)(p.in[I_GLRU] + 8 * lane + 4);
    for (int rr = wave; rr < 128; rr += 32) {
        u32x4 a[4], b[4];
#pragma unroll
        for (int q = 0; q < 4; ++q) { const int r = row0 + rr + 8 * q; a[q] = *(const u32x4*)(Y1 + (size_t)r * LW + 8 * lane); b[q] = *(const u32x4*)(Y2 + (size_t)r * LW + 8 * lane); }
#pragma unroll
        for (int q = 0; q < 4; ++q) {
            const int r = row0 + rr + 8 * q;
            float v[8];
            v[0] = __uint_as_float(a[q].x << 16) + c0[0] * __uint_as_float(b[q].x << 16); v[1] = __uint_as_float(a[q].x & 0xffff0000u) + c0[1] * __uint_as_float(b[q].x & 0xffff0000u);
            v[2] = __uint_as_float(a[q].y << 16) + c0[2] * __uint_as_float(b[q].y << 16); v[3] = __uint_as_float(a[q].y & 0xffff0000u) + c0[3] * __uint_as_float(b[q].y & 0xffff0000u);
            v[4] = __uint_as_float(a[q].z << 16) + c1[0] * __uint_as_float(b[q].z << 16); v[5] = __uint_as_float(a[q].z & 0xffff0000u) + c1[1] * __uint_as_float(b[q].z & 0xffff0000u);
            v[6] = __uint_as_float(a[q].w << 16) + c1[2] * __uint_as_float(b[q].w << 16); v[7] = __uint_as_float(a[q].w & 0xffff0000u) + c1[3] * __uint_as_float(b[q].w & 0xffff0000u);
            float sq = 0.f;
#pragma unroll
            for (int i = 0; i < 8; ++i) sq += v[i] * v[i];
            const float rs = __builtin_amdgcn_rsqf(wave_sum(sq) * (1.f / LW) + EPS);
            u32x4 w; w.x = pk2(v[0] * rs * g0[0], v[1] * rs * g0[1]); w.y = pk2(v[2] * rs * g0[2], v[3] * rs * g0[3]);
            w.z = pk2(v[4] * rs * g1[0], v[5] * rs * g1[1]); w.w = pk2(v[6] * rs * g1[2], v[7] * rs * g1[3]);
            *(u32x4*)(mix + (size_t)r * DM + 512 + 8 * lane) = w;
        }
    }
    __syncthreads();
}

template <class Epi>
__device__ __forceinline__ void sgemm_n1024(LAS unsigned char* lds, const bf16_t* A, int lda, const bf16_t* Bt, int K, const Epi& E, int bx, int G, int wave, int lane) {
    const int fr = lane & 15, fq = lane >> 4, g = wave >> 2, kq = wave & 3, nkq = K / 256;
    for (int T0 = bx * 2; T0 < 512; T0 += 2 * G) {
        const int T = T0 + g, ct = T >> 5, rt = T & 31, row0 = MP + rt * 32;
        const bf16_t* ap = A + (size_t)(row0 + fr) * lda + kq * (K / 4) + 8 * fq;
        const bf16_t* bp = Bt + (size_t)(ct * 64 + fr) * K + kq * (K / 4) + 8 * fq;
        f32x4 acc[2][4];
#pragma unroll
        for (int mi = 0; mi < 2; ++mi)
#pragma unroll
            for (int ni = 0; ni < 4; ++ni) acc[mi][ni] = (f32x4){0.f, 0.f, 0.f, 0.f};
        bf16x8 fa[2][2][2], fb[2][4][2];
#define SG_LOAD(s, kk) do { const int ko_ = ((kk) < nkq ? (kk) : nkq - 1) * 64; \
        _Pragma("unroll") for (int mi = 0; mi < 2; ++mi) _Pragma("unroll") for (int ks = 0; ks < 2; ++ks) fa[s][mi][ks] = *(const bf16x8*)(ap + (size_t)mi * 16 * lda + ko_ + ks * 32); \
        _Pragma("unroll") for (int ni = 0; ni < 4; ++ni) _Pragma("unroll") for (int ks = 0; ks < 2; ++ks) fb[s][ni][ks] = *(const bf16x8*)(bp + (size_t)ni * 16 * K + ko_ + ks * 32); } while (0)
#define SG_MMA(s) do { _Pragma("unroll") for (int mi = 0; mi < 2; ++mi) _Pragma("unroll") for (int ni = 0; ni < 4; ++ni) _Pragma("unroll") for (int ks = 0; ks < 2; ++ks) \
        acc[mi][ni] = __builtin_amdgcn_mfma_f32_16x16x32_bf16(fb[s][ni][ks], fa[s][mi][ks], acc[mi][ni], 0, 0, 0); } while (0)
#define SG_SCHED __builtin_amdgcn_sched_barrier(0)
        SG_LOAD(0, 0); SG_SCHED;
        for (int k = 0; k < nkq; k += 2) {
            SG_LOAD(1, k + 1); SG_SCHED; SG_MMA(0); SG_SCHED;
            SG_LOAD(0, k + 2); SG_SCHED; if (k + 1 < nkq) SG_MMA(1); SG_SCHED;
        }
#undef SG_LOAD
#undef SG_MMA
#undef SG_SCHED
        LAS f32x4* red = (LAS f32x4*)lds;
        if (kq) {
#pragma unroll
            for (int mi = 0; mi < 2; ++mi)
#pragma unroll
                for (int ni = 0; ni < 4; ++ni) red[((g * 3 + (kq - 1)) * 64 + lane) * 8 + mi * 4 + ni] = acc[mi][ni];
        }
        __syncthreads();
        if (kq == 0) {
#pragma unroll
            for (int j = 0; j < 3; ++j)
#pragma unroll
                for (int mi = 0; mi < 2; ++mi)
#pragma unroll
                    for (int ni = 0; ni < 4; ++ni) acc[mi][ni] = acc[mi][ni] + red[((g * 3 + j) * 64 + lane) * 8 + mi * 4 + ni];
            E(acc, row0, ct, fr, fq);
        }
        __syncthreads();
    }
}
__device__ __forceinline__ u32x2 pk4(const f32x4 v) { u32x2 w; w.x = pk2(v[0], v[1]); w.y = pk2(v[2], v[3]); return w; }
__device__ __forceinline__ f32x4 unpk4(const u32x2 w) { return (f32x4){__uint_as_float(w.x << 16), __uint_as_float(w.x & 0xffff0000u), __uint_as_float(w.y << 16), __uint_as_float(w.y & 0xffff0000u)}; }
__device__ __forceinline__ float srow_rs(const float* sss, int r) {
    const float* q = sss + (size_t)(r - MP) * 16 * 32; float t = 0.f;
#pragma unroll
    for (int i = 0; i < 16; ++i) t += q[i * 32];
    return __builtin_amdgcn_rsqf(t * (1.f / DM) + EPS);
}
template <bool F32BASE> struct SEpiResid {
    const float* base_s; bf16_t* hb; float* ss;
    __device__ __forceinline__ void operator()(const f32x4 (&acc)[2][4], int row0, int ct, int fr, int fq) const {
#pragma unroll
        for (int mi = 0; mi < 2; ++mi) {
            const int r = row0 + mi * 16 + fr; float s = 0.f;
#pragma unroll
            for (int ni = 0; ni < 4; ++ni) { const int c = ct * 64 + ni * 16 + 4 * fq;
                f32x4 v = F32BASE ? *(const f32x4*)(base_s + (size_t)(r - MP) * DM + c) : unpk4(*(const u32x2*)(hb + (size_t)r * DM + c));
                v = v + acc[mi][ni]; s += (v[0] * v[0] + v[1] * v[1]) + (v[2] * v[2] + v[3] * v[3]);
                *(u32x2*)(hb + (size_t)r * DM + c) = pk4(v); }
            s += __shfl_xor(s, 16); s += __shfl_xor(s, 32);
            if (fq == 0) ss[((size_t)(r - MP) * 16 + ct) * 32] = s;
        }
    }
};

struct SEpiPleGate {
    const float* ss; const bf16_t* pp; const bf16_t* h2; bf16_t* h3;
    __device__ __forceinline__ void operator()(const f32x4 (&acc)[2][4], int row0, int ct, int fr, int fq) const {
#pragma unroll
        for (int mi = 0; mi < 2; ++mi) {
            const int r = row0 + mi * 16 + fr; const float rs = srow_rs(ss, r);
#pragma unroll
            for (int ni = 0; ni < 4; ++ni) { const size_t o = (size_t)r * DM + ct * 64 + ni * 16 + 4 * fq;
                const f32x4 pv = unpk4(*(const u32x2*)(pp + o)); f32x4 h = unpk4(*(const u32x2*)(h2 + o)); const f32x4 a = acc[mi][ni];
#pragma unroll
                for (int i = 0; i < 4; ++i) h[i] += pv[i] * sigmoid_f(a[i] * rs);
                *(u32x2*)(h3 + o) = pk4(h); }
        }
    }
};


#define XB_TMO      128
#define XB_XCNT(j)  (256  + 64 * (j))
#define XB_XSUB(j)  (1280 + 64 * (j))
#define XB_XGEN(j)  (2304 + 64 * (j))
#define XB_TOP      3328
#define XB_TOPGEN   3392
#define XCD_BAR_WORDS 3456
#define XB_SPIN_CAP (1u << 18)

__device__ __forceinline__ unsigned xb_ld(unsigned* p)              { return __hip_atomic_load(p, __ATOMIC_RELAXED, __HIP_MEMORY_SCOPE_AGENT); }
__device__ __forceinline__ unsigned xb_add(unsigned* p, unsigned v) { return __hip_atomic_fetch_add(p, v, __ATOMIC_RELAXED, __HIP_MEMORY_SCOPE_AGENT); }
__device__ __forceinline__ unsigned xb_xcc_id() { return (unsigned)__builtin_amdgcn_s_getreg((3 << 11) | 20) & 0xFu; }
#define XB_SPIN(cond, bar) do { unsigned _sp = 0; while (cond) { __builtin_amdgcn_s_sleep(1); \
    if ((++_sp & 255u) == 0u) { if (xb_ld(&(bar)[XB_TMO])) break; if (_sp > XB_SPIN_CAP) { atomicAdd(&(bar)[XB_TMO], 1u); break; } } } } while (0)

struct XcdBarrier { unsigned* bar; unsigned x; volatile LAS unsigned* st; };
__device__ __forceinline__ XcdBarrier xcd_barrier_post(unsigned* bar, volatile LAS unsigned* st, bool leader) {
    XcdBarrier b; b.bar = bar; b.x = xb_xcc_id(); b.st = st;
    if (leader) (void)xb_add(&bar[XB_XCNT(b.x)], 1u);
    return b;
}
__device__ __forceinline__ void xcd_barrier_complete(unsigned* bar, unsigned x, unsigned& nloc, unsigned& nx) {
    const unsigned G = gridDim.x * gridDim.y * gridDim.z;
    unsigned sum, cnt, mine, sp = 0u;
    for (;;) {
        sum = 0u; cnt = 0u; mine = 0u;
#pragma unroll
        for (unsigned j = 0; j < 16; ++j) { const unsigned c = xb_ld(&bar[XB_XCNT(j)]); sum += c; cnt += (c > 0u) ? 1u : 0u; mine = (j == x) ? c : mine; }
        if (sum == G) break;
        __builtin_amdgcn_s_sleep(1);
        if ((++sp & 255u) == 0u) { if (xb_ld(&bar[XB_TMO])) break; if (sp > XB_SPIN_CAP) { atomicAdd(&bar[XB_TMO], 1u); break; } }
    }
    nloc = mine > 0u ? mine : 1u; nx = cnt > 0u ? cnt : 1u;
}

__device__ __forceinline__ void xcd_barrier(const XcdBarrier& b, bool leader) {
    asm volatile("s_waitcnt vmcnt(0)" ::: "memory");
    __syncthreads();
    if (leader) {
        unsigned* bar = b.bar;
        __builtin_amdgcn_s_waitcnt(0);
        unsigned nloc = b.st[0], nx = b.st[1];
        if (nloc == 0u) { xcd_barrier_complete(bar, b.x, nloc, nx); b.st[0] = nloc; b.st[1] = nx; }
        const unsigned old = xb_add(&bar[XB_XSUB(b.x)], 1u);
        const unsigned gen = old / nloc;
        if (old + 1u == (gen + 1u) * nloc) {
            __builtin_amdgcn_fence(__ATOMIC_RELEASE, "agent");
            asm volatile("s_waitcnt vmcnt(0)" ::: "memory");
            const unsigned og = xb_add(&bar[XB_TOP], 1u);
            const unsigned tg = og / nx;
            if (og + 1u == (tg + 1u) * nx) xb_add(&bar[XB_TOPGEN], 1u);
            else XB_SPIN(xb_ld(&bar[XB_TOPGEN]) == tg, bar);
            __builtin_amdgcn_fence(__ATOMIC_ACQUIRE, "agent");
            xb_add(&bar[XB_XGEN(b.x)], 1u);
            asm volatile("s_waitcnt vmcnt(0)" ::: "memory");
        } else {
            XB_SPIN(xb_ld(&bar[XB_XGEN(b.x)]) == gen, bar);
            __builtin_amdgcn_fence(__ATOMIC_ACQUIRE, "agent");
            asm volatile("s_waitcnt vmcnt(0)" ::: "memory");
        }
    }
    __syncthreads();
}

__global__ void __launch_bounds__(512, 2) fwd_megakernel(Params p) {
    extern __shared__ __attribute__((aligned(16))) unsigned char lds_raw[];
    LAS unsigned char* lds = (LAS unsigned char*)lds_raw;
    cg::grid_group grid = cg::this_grid();
    const int wave = __builtin_amdgcn_readfirstlane((int)threadIdx.x >> 6);
#define LANE_NOW(l) int l = __builtin_amdgcn_mbcnt_hi(~0u, __builtin_amdgcn_mbcnt_lo(~0u, 0u)); asm volatile("" : "+v"(l))
    const int G = gridDim.x, bx = blockIdx.x;
    unsigned char* ws = p.ws;
    const int lo = p.ph_lo, hi = p.ph_hi;
    { LANE_NOW(l0_); if (wave == 0 && l0_ < 2) ((volatile LAS unsigned*)(lds + 131072))[l0_] = 0u; }
    __syncthreads();
    XcdBarrier xbar; xbar.bar = (unsigned*)(ws + WS_BAR); xbar.x = 0; xbar.st = (volatile LAS unsigned*)(lds + 131072);
    if (lo == 0 && hi > 1) {
        if (bx == 0) { LANE_NOW(l0_); const int t_ = wave * 64 + l0_;
            for (int i = t_; i < XCD_BAR_WORDS; i += 512) __hip_atomic_store((unsigned*)(ws + WS_BAR) + i, 0u, __ATOMIC_RELAXED, __HIP_MEMORY_SCOPE_AGENT);
            if (t_ < 16) __hip_atomic_store((unsigned*)(ws + WS_CTR) + 64 * t_, 0u, __ATOMIC_RELAXED, __HIP_MEMORY_SCOPE_AGENT);
            asm volatile("s_waitcnt vmcnt(0)" ::: "memory"); }
        grid.sync();
        { LANE_NOW(l0_); xbar = xcd_barrier_post((unsigned*)(ws + WS_BAR), (volatile LAS unsigned*)(lds + 131072), wave == 0 && l0_ == 0); }
    }
#ifndef REP0
#define REP0 1
#endif
#ifndef REP2
#define REP2 1
#endif
#ifndef REP1
#define REP1 1
#endif
#ifndef REP3
#define REP3 1
#endif
#ifndef REP4
#define REP4 1
#endif
#ifndef REP5
#define REP5 1
#endif
#ifndef PHMASK
#define PHMASK 0x1ff
#endif
#define IN(k) (((PHMASK >> (k)) & 1) && lo <= (k) && (k) < hi)
#define SEAM(k) do { if (IN(k) && IN((k) + 1)) { LANE_NOW(l0_); xcd_barrier(xbar, wave == 0 && l0_ == 0); } } while (0)

    for (int rep0 = 0; rep0 < REP0; ++rep0) if (IN(0)) { LANE_NOW(lane);  p0_prologue(p, lds, wave, lane, 0, bx * 8 + wave, G * 8); }
    SEAM(0);
    for (int rep1 = 0; rep1 < REP1; ++rep1) if (IN(1)) {
        pg8::Gemm g{(const bf16_t*)(ws + WS_XN), (const bf16_t*)(ws + WS_WIN), MT, INW, DM}; pg8::StaticOrder S; S.init(MT, INW, G, bx);
        pg8::EpiInProj E{(bf16_t*)(ws + WS_PROJ), (bf16_t*)(ws + WS_VT), p.out, lds + 131072 + 256};
        pg8::gemm_phase<pg8::EpiInProj, pg8::StaticOrder, true, true>(lds, g, S, E, wave);
    }
    SEAM(1);
    for (int rep2 = 0; rep2 < REP2; ++rep2) if (IN(2)) {
        LANE_NOW(lane); const int tid = wave * 64 + lane;
        for (int i = tid; i < NHEAD * RELSZ; i += 512) ((LAS float*)lds)[i] = p.in[I_REL][i] * LOG2E;
        __syncthreads();
        constexpr int N_LRU = 160, N_ATT = NBATCH * 256;
        unsigned* ctr = (unsigned*)(ws + WS_CTR);
        volatile LAS int* qslot = (volatile LAS int*)(lds + 12288);
#define Q_NEXT(k, it) do { if (tid == 0) qslot[0] = (int)__hip_atomic_fetch_add(ctr + 64 * (k), 1u, __ATOMIC_RELAXED, __HIP_MEMORY_SCOPE_AGENT); __syncthreads(); it = qslot[0]; __syncthreads(); } while (0)
#ifndef NO_LRU
        for (;;) { int it; Q_NEXT(0, it); if (it >= N_LRU) break; lru_item(p, lds, wave, lane, it); }
#endif
        asm volatile("" ::: "memory");
#ifndef NO_ATT4
        { const int myq = (int)(xb_xcc_id() & 7u);
          for (;;) {
              if (tid == 0) {
                  int q = myq; int it = (int)__hip_atomic_fetch_add(ctr + 64 * (4 + q), 1u, __ATOMIC_RELAXED, __HIP_MEMORY_SCOPE_AGENT);
                  while (it >= 64) {
                      int best = -1; unsigned bestv = 64u;
                      for (int j = 0; j < 8; ++j) { const unsigned v = __hip_atomic_load(ctr + 64 * (4 + j), __ATOMIC_RELAXED, __HIP_MEMORY_SCOPE_AGENT); if (v < bestv) { bestv = v; best = j; } }
                      if (best < 0) { q = -1; break; }
                      q = best; it = (int)__hip_atomic_fetch_add(ctr + 64 * (4 + q), 1u, __ATOMIC_RELAXED, __HIP_MEMORY_SCOPE_AGENT);
                  }
                  qslot[0] = q < 0 ? -1 : ((q << 8) | it);
              }
              __syncthreads(); const int v = qslot[0]; __syncthreads();
              if (v < 0) break;
              attn_item<4>(p, lds, wave, lane, false, v >> 10, ((v >> 8) & 3) * 64 + (v & 255));
          } }
#endif
        asm volatile("" ::: "memory");
#ifndef NO_ATT2
        for (;;) { int it; Q_NEXT(2, it); if (it >= SBATCH) break; attn_item<2>(p, lds, wave, lane, true, it, 0); }
#endif
#undef Q_NEXT
        __syncthreads();
    }
    SEAM(2);
    for (int rep3 = 0; rep3 < REP3; ++rep3) if (IN(3)) { LANE_NOW(lane); for (int it = bx; it < 264; it += G) fixup_item(p, lds, wave, lane, it); }
    SEAM(3);
    for (int rep4 = 0; rep4 < REP4; ++rep4) if (IN(4)) {
        pg8::Gemm g{(const bf16_t*)(ws + WS_MIX), (const bf16_t*)(ws + WS_WO), MT, DM, DM}; pg8::StaticOrder S; S.init(MT, DM, G, bx);
        pg8::EpiResid<true> E{p.in[I_XP], p.in[I_XS], (bf16_t*)(ws + WS_XN), (float*)(ws + WS_SS1)};
        pg8::gemm_phase<pg8::EpiResid<true>, pg8::StaticOrder, true, true>(lds, g, S, E, wave);
        __syncthreads();
        { const int n3 = (MT / 256) * (DM / 256) - 2 * G; const bool spread = n3 > 0 && n3 < G;
          pg8::Gemm g2{(const bf16_t*)(ws + WS_PB), (const bf16_t*)(ws + WS_WPP), MT, DM, PLE}; pg8::StaticOrder S2;
          if (spread) S2.init(MT, DM, G - n3, bx >= n3 ? bx - n3 : (1 << 28)); else S2.init(MT, DM, G, bx);
          pg8::EpiStoreBf16 E2{(bf16_t*)(p.out + OFF_Y)};
          pg8::gemm_phase<pg8::EpiStoreBf16, pg8::StaticOrder, true, true>(lds, g2, S2, E2, wave);
          __syncthreads();
          LANE_NOW(lane);
          if (spread) { if (bx >= n3) p0_prologue(p, lds, wave, lane, 1, (bx - n3) * 8 + wave, (G - n3) * 8); } else p0_prologue(p, lds, wave, lane, 1, bx * 8 + wave, G * 8); }
    }
    SEAM(4);
    for (int rep5 = 0; rep5 < REP5; ++rep5) if (IN(5)) {
        pg8::Gemm g{(const bf16_t*)(ws + WS_XN), (const bf16_t*)(ws + WS_WGU), MT, 2 * DFF, DM}; pg8::StaticOrder S; S.init(MT, 2 * DFF, G, bx);
        pg8::EpiSwiglu E{(const float*)(ws + WS_SS1), (bf16_t*)(ws + WS_PROJ)};
        pg8::gemm_phase<pg8::EpiSwiglu, pg8::StaticOrder, true, true>(lds, g, S, E, wave);
    }
    SEAM(5);
    if (IN(6)) {
        pg8::Gemm g{(const bf16_t*)(ws + WS_PROJ), (const bf16_t*)(ws + WS_WD), MP, DM, DFF}; pg8::StaticOrder S; S.init(MP, DM, G, bx);
        pg8::EpiResid<false> E{nullptr, nullptr, (bf16_t*)(ws + WS_XN), (float*)(ws + WS_SS2)};
        pg8::gemm_phase<pg8::EpiResid<false>, pg8::StaticOrder, true, true>(lds, g, S, E, wave);
        __syncthreads();
        { LANE_NOW(lane); SEpiResid<false> SE{nullptr, (bf16_t*)(ws + WS_XN), (float*)(ws + WS_SSS2)};
          sgemm_n1024<SEpiResid<false>>(lds, (const bf16_t*)(ws + WS_PROJ), DFF, (const bf16_t*)(ws + WS_WD), DFF, SE, bx, G, wave, lane); }
    }
    SEAM(6);
    if (IN(7)) {
#ifndef NO_P7B
        { pg8::Gemm g{(const bf16_t*)(ws + WS_XN), (const bf16_t*)(ws + WS_WPG), MP, DM, DM}; pg8::StaticOrder S; S.init(MP, DM, G, bx);
          pg8::EpiPleGate E{(const float*)(ws + WS_SS2), (const float*)(ws + WS_SSS2), (const bf16_t*)(p.out + OFF_Y), (const bf16_t*)(ws + WS_XN), (bf16_t*)(ws + WS_MIX)};
          pg8::gemm_phase<pg8::EpiPleGate, pg8::StaticOrder, true, true>(lds, g, S, E, wave); }
#endif
        __syncthreads();
        { LANE_NOW(lane); SEpiPleGate SE{(const float*)(ws + WS_SSS2), (const bf16_t*)(p.out + OFF_Y), (const bf16_t*)(ws + WS_XN), (bf16_t*)(ws + WS_MIX)};
          sgemm_n1024<SEpiPleGate>(lds, (const bf16_t*)(ws + WS_XN), DM, (const bf16_t*)(ws + WS_WPG), DM, SE, bx, G, wave, lane); }
    }
    SEAM(7);
    if (IN(8)) {
        LANE_NOW(lane);
        const f32x4* gf = (const f32x4*)p.in[I_GFINAL];
        const bf16_t* h3 = (const bf16_t*)(ws + WS_MIX);
        for (int m0 = bx * 8 + wave; m0 < MT; m0 += 2 * G * 8) {
            const int m1 = (m0 + G * 8 < MT) ? m0 + G * 8 : m0;
            u32x4 ld[2][2];
            ld[0][0] = ((const u32x4*)(h3 + (size_t)m0 * DM))[lane]; ld[0][1] = ((const u32x4*)(h3 + (size_t)m0 * DM))[lane + 64];
            ld[1][0] = ((const u32x4*)(h3 + (size_t)m1 * DM))[lane]; ld[1][1] = ((const u32x4*)(h3 + (size_t)m1 * DM))[lane + 64];
#pragma unroll
            for (int q = 0; q < 2; ++q) {
                if (q == 1 && m1 == m0) break;
                const int m = q ? m1 : m0; const u32x4 a = ld[q][0], b = ld[q][1];
                float v[16];
                v[0] = __uint_as_float(a.x << 16); v[1] = __uint_as_float(a.x & 0xffff0000u); v[2] = __uint_as_float(a.y << 16); v[3] = __uint_as_float(a.y & 0xffff0000u);
                v[4] = __uint_as_float(a.z << 16); v[5] = __uint_as_float(a.z & 0xffff0000u); v[6] = __uint_as_float(a.w << 16); v[7] = __uint_as_float(a.w & 0xffff0000u);
                v[8] = __uint_as_float(b.x << 16); v[9] = __uint_as_float(b.x & 0xffff0000u); v[10] = __uint_as_float(b.y << 16); v[11] = __uint_as_float(b.y & 0xffff0000u);
                v[12] = __uint_as_float(b.z << 16); v[13] = __uint_as_float(b.z & 0xffff0000u); v[14] = __uint_as_float(b.w << 16); v[15] = __uint_as_float(b.w & 0xffff0000u);
                float sq = 0.f;
#pragma unroll
                for (int i = 0; i < 16; ++i) sq += v[i] * v[i];
                const float rs = __builtin_amdgcn_rsqf(wave_sum(sq) * (1.f / DM) + EPS);
                f32x4* yr = (f32x4*)(p.out + OFF_Y + (size_t)m * DM);
#pragma unroll
                for (int qq = 0; qq < 4; ++qq) { const int ci = (qq < 2 ? 2 * lane + qq : 128 + 2 * lane + (qq - 2)); const f32x4 g = gf[ci];
                    yr[ci] = (f32x4){v[4 * qq] * rs * g[0], v[4 * qq + 1] * rs * g[1], v[4 * qq + 2] * rs * g[2], v[4 * qq + 3] * rs * g[3]}; }
            }
        }
    }
#undef IN
#undef SEAM
}

extern "C" void kernel_launch(void* const* d_in, const int* in_sizes, int n_in, void* d_out, int out_size, void* d_ws, size_t ws_size, hipStream_t stream) {
    static int grid = 0;
    if (grid == 0) {
        if (n_in != 29 || (size_t)out_size != OUT_TOTAL || ws_size < WS_END) { fprintf(stderr, "kernel_launch: shape mismatch (n_in %d, out %d, ws %zu need %zu)\n", n_in, out_size, ws_size, (size_t)WS_END); grid = -1; return; }
        int dev = 0, cus = 0, per_cu = 0;
        hipGetDevice(&dev); hipDeviceGetAttribute(&cus, hipDeviceAttributeMultiprocessorCount, dev);
        if (hipFuncSetAttribute((const void*)fwd_megakernel, hipFuncAttributeMaxDynamicSharedMemorySize, LDS_BYTES) != hipSuccess) { fprintf(stderr, "kernel_launch: hipFuncSetAttribute failed\n"); grid = -1; return; }
        if (hipOccupancyMaxActiveBlocksPerMultiprocessor(&per_cu, (const void*)fwd_megakernel, 512, LDS_BYTES) != hipSuccess || per_cu < 1) { fprintf(stderr, "kernel_launch: occupancy query says %d\n", per_cu); per_cu = 1; }
        (void)hipGetLastError();
        grid = cus * (per_cu > 1 ? 1 : per_cu);
    }
    if (grid < 0) return;
    Params p{};
    for (int i = 0; i < 29; ++i) p.in[i] = (const float*)d_in[i];
    p.out = (float*)d_out; p.ws = (unsigned char*)d_ws;
#if MK_N_LAUNCHES == 1
    p.ph_lo = 0; p.ph_hi = 9;
    void* args[] = {&p};
    hipError_t e = hipLaunchCooperativeKernel((const void*)fwd_megakernel, dim3(grid), dim3(512), args, LDS_BYTES, stream);
    if (e != hipSuccess) fprintf(stderr, "cooperative launch failed: %s (grid %d)\n", hipGetErrorString(e), grid);
#else
    for (int k = 0; k < 9; ++k) { p.ph_lo = k; p.ph_hi = k + 1; hipLaunchKernelGGL(fwd_megakernel, dim3(grid), dim3(512), LDS_BYTES, stream, p); }
#endif
}
```

```cpp
#include <hip/hip_runtime.h>
#include <hip/hip_cooperative_groups.h>
#include <cstdio>
#include <cstdint>
namespace cg = cooperative_groups;
namespace pg8 {
#define PG8_LAS __attribute__((address_space(3)))
typedef unsigned short bf16_t;
typedef short bf16x8 __attribute__((ext_vector_type(8)));
typedef float f32x4 __attribute__((ext_vector_type(4)));
typedef unsigned u32x4 __attribute__((ext_vector_type(4)));
constexpr int BM = 256, BK = 64, HALF = 128, HTB = HALF * BK * 2  , STAGE_BYTES = 8 * HTB, NXCD = 8, WGM = 8;

__host__ __device__ __forceinline__ int lds_byte(int r, int c) { const int st = (r >> 4) * 2 + (c >> 5), rr = r & 15, cc = c & 31, ob = rr * 64 + cc * 2; return st * 1024 + (ob ^ (((ob >> 9) & 1) << 5)); }
__host__ __device__ __forceinline__ void stage_rc(int b, int& R, int& C) { const int st = b / 1024, sb = b % 1024, swz = sb ^ (((sb >> 9) & 1) << 5); R = (st >> 1) * 16 + swz / 64; C = (st & 1) * 32 + (swz % 64) / 2; }
__host__ __device__ __forceinline__ int perm32(int rho) { const int n = rho >> 4, i = rho & 15; return 8 * (i >> 2) + 4 * n + (i & 3); }

struct Unit { int pm, pn; };
struct Gemm { const bf16_t* A; const bf16_t* Bt; int M, N, K; };

struct StaticOrder {
    int nM, nN, nwg, G, c;
    __host__ __device__ void init(int M, int N, int G_, int c_) { nM = M / BM; nN = N / BM; nwg = nM * nN; G = G_; c = c_; }
    __host__ __device__ bool next(int i, Unit& u) const {
        const long L = (long)i * G + c; if (L >= nwg) return false;
        int wgid = (int)L; { const int q = nwg / NXCD, r = nwg % NXCD, xcd = wgid % NXCD, off = wgid / NXCD; wgid = (xcd < r ? xcd * (q + 1) : r * (q + 1) + (xcd - r) * q) + off; }
        const int nig = WGM * nN, gid = wgid / nig, fm = gid * WGM, gsz = (nM - fm) < WGM ? (nM - fm) : WGM;
        u.pm = fm + ((wgid % nig) % gsz); u.pn = (wgid % nig) / gsz; return true;
    }
    __device__ __forceinline__ void a_ready(const Unit&) const {}
    __device__ __forceinline__ void done(const Unit&) const {}
};
__device__ __forceinline__ unsigned cvt_pk_bf16(float lo, float hi) { unsigned r; asm volatile("v_cvt_pk_bf16_f32 %0, %1, %2" : "=v"(r) : "v"(lo), "v"(hi)); return r; }
template <class Epi, class Sched, bool ALIGN_EPI = false, bool SP2 = false>
__device__ __forceinline__ void gemm_phase(PG8_LAS unsigned char* lds, const Gemm g, const Sched& S, const Epi& E, const int wave_s) {
    int lane_o = __builtin_amdgcn_mbcnt_hi(~0u, __builtin_amdgcn_mbcnt_lo(~0u, 0u)); asm volatile("" : "+v"(lane_o));
    const int wid = wave_s, lane = lane_o, tid = wave_s * 64 + lane_o, wr = wid >> 2, wc = wid & 3, fr = lane & 15, fq = lane >> 4;
    int K_o = g.K; asm volatile("" : "+s"(K_o));
    const int K = K_o, nt = K / BK;
    unsigned voffA[2], voffB[2];
#pragma unroll
    for (int i = 0; i < 2; ++i) { int R, C; stage_rc(tid * 16 + i * 8192, R, C); const int Rb = Epi::PERM ? ((R & ~31) + perm32(R & 31)) : R;
        voffA[i] = (unsigned)(R * K + C) * 2u; voffB[i] = (unsigned)(Rb * K + C) * 2u; }
    const size_t kstep = (size_t)(BK * 2);
    const size_t hstep = (size_t)HALF * K * 2;
    const size_t tstep = 2 * hstep;
    const unsigned ldsw = (unsigned)wid * 1024u;
    const int aoff = lds_byte(wr * 64 + fr, fq * 8), boff = lds_byte(wc * 32 + fr, fq * 8);
#define PG8_SA(b, h) (((b) * 2 + (h)) * HTB)
#define PG8_SB(b, h) ((4 + (b) * 2 + (h)) * HTB)
#define PG8_STAGE(bufoff, gbase, voff) do { _Pragma("unroll") for (int _i = 0; _i < 2; ++_i) \
        __builtin_amdgcn_global_load_lds((const unsigned*)((const char*)(gbase) + (voff)[_i]), (PG8_LAS unsigned*)(lds + (bufoff) + ldsw + _i * 8192), 16, 0, 0); } while (0)
#define PG8_LDA(dst, b, h) do { _Pragma("unroll") for (int m = 0; m < 4; ++m) _Pragma("unroll") for (int k = 0; k < 2; ++k) dst[m][k] = *(const PG8_LAS bf16x8*)(lds + PG8_SA(b, h) + aoff + m * 2048 + k * 1024); } while (0)
#define PG8_LDB(dst, b, h) do { _Pragma("unroll") for (int n = 0; n < 2; ++n) _Pragma("unroll") for (int k = 0; k < 2; ++k) dst[n][k] = *(const PG8_LAS bf16x8*)(lds + PG8_SB(b, h) + boff + n * 2048 + k * 1024); } while (0)
#define PG8_MMA(ai, bj, At, Bt) do { __builtin_amdgcn_s_setprio(1); _Pragma("unroll") for (int m = 0; m < 4; ++m) _Pragma("unroll") for (int n = 0; n < 2; ++n) _Pragma("unroll") for (int k = 0; k < 2; ++k) \
        acc[ai][bj][m][n] = __builtin_amdgcn_mfma_f32_16x16x32_bf16(Bt[n][k], At[m][k], acc[ai][bj][m][n], 0, 0, 0); __builtin_amdgcn_s_setprio(0); } while (0)
#define PG8_WAIT_V(n) asm volatile("s_waitcnt vmcnt(" #n ")" ::: "memory")
#define PG8_WAIT_L(n) asm volatile("s_waitcnt lgkmcnt(" #n ")" ::: "memory")
#define PG8_BAR __builtin_amdgcn_s_barrier()
#define PG8_SCHED __builtin_amdgcn_sched_barrier(0)
    Unit cur, nxt; int ui = 0;
    if (!S.next(0, cur)) return;
    f32x4 acc[2][2][4][2];
#pragma unroll
    for (int a = 0; a < 2; ++a)
#pragma unroll
        for (int b = 0; b < 2; ++b)
#pragma unroll
            for (int m = 0; m < 4; ++m)
#pragma unroll
                for (int n = 0; n < 2; ++n) acc[a][b][m][n] = (f32x4){0.f, 0.f, 0.f, 0.f};
    bf16x8 At[4][2], B0[2][2], B1[2][2];
    const char* cA = (const char*)g.A + (size_t)cur.pm * tstep; const char* cB = (const char*)g.Bt + (size_t)cur.pn * tstep;
    S.a_ready(cur);
    if constexpr (SP2) {
        PG8_STAGE(PG8_SB(0, 0), cB, voffB); PG8_STAGE(PG8_SB(0, 1), cB + hstep, voffB); PG8_STAGE(PG8_SA(0, 0), cA, voffA); PG8_STAGE(PG8_SA(0, 1), cA + hstep, voffA);
        if (wr == 1) PG8_BAR;
        PG8_WAIT_V(2); PG8_BAR;
        PG8_STAGE(PG8_SB(1, 0), cB + kstep, voffB); PG8_STAGE(PG8_SA(1, 0), cA + kstep, voffA); PG8_STAGE(PG8_SB(1, 1), cB + hstep + kstep, voffB);
        PG8_WAIT_V(6); PG8_BAR;
    } else {
        PG8_STAGE(PG8_SB(0, 0), cB, voffB); PG8_STAGE(PG8_SA(0, 0), cA, voffA); PG8_STAGE(PG8_SB(0, 1), cB + hstep, voffB); PG8_STAGE(PG8_SA(0, 1), cA + hstep, voffA);
        if (wr == 1) PG8_BAR;
        PG8_WAIT_V(4); PG8_BAR;
        PG8_STAGE(PG8_SB(1, 0), cB + kstep, voffB); PG8_STAGE(PG8_SA(1, 0), cA + kstep, voffA); PG8_STAGE(PG8_SB(1, 1), cB + hstep + kstep, voffB);
        PG8_WAIT_V(6); PG8_BAR;
    }
    for (;;) {
        const bool has_next = S.next(ui + 1, nxt);
        const char* nA = has_next ? (const char*)g.A + (size_t)nxt.pm * tstep : cA; const char* nB = has_next ? (const char*)g.Bt + (size_t)nxt.pn * tstep : cB;
        for (int t = 0; t < nt; t += 2) {
            const bool last = (t == nt - 2);
            const char* a1 = cA + (size_t)(t + 1) * kstep;
            const char* a2 = last ? nA : cA + (size_t)(t + 2) * kstep; const char* b2 = last ? nB : cB + (size_t)(t + 2) * kstep;
            const char* a3 = a2 + kstep; const char* b3 = b2 + kstep;
            if (last && has_next) S.a_ready(nxt);
            if constexpr (SP2) {
            PG8_LDB(B0, 0, 0); PG8_LDB(B1, 0, 1); PG8_SCHED; PG8_LDA(At, 0, 0); PG8_STAGE(PG8_SA(1, 1), a1 + hstep, voffA);
            PG8_WAIT_V(8); PG8_WAIT_L(0); PG8_BAR; PG8_MMA(0, 0, At, B0); PG8_MMA(0, 1, At, B1); PG8_BAR; PG8_SCHED;
            PG8_LDA(At, 0, 1); PG8_STAGE(PG8_SB(0, 0), b2, voffB); PG8_STAGE(PG8_SB(0, 1), b2 + hstep, voffB); PG8_STAGE(PG8_SA(0, 0), a2, voffA);
            PG8_WAIT_V(8); PG8_WAIT_L(0); PG8_BAR; PG8_MMA(1, 0, At, B0); PG8_MMA(1, 1, At, B1); PG8_BAR; PG8_SCHED;
            PG8_LDB(B0, 1, 0); PG8_LDB(B1, 1, 1); PG8_SCHED; PG8_LDA(At, 1, 0); PG8_STAGE(PG8_SA(0, 1), a2 + hstep, voffA);
            PG8_WAIT_V(8); PG8_WAIT_L(0); PG8_BAR; PG8_MMA(0, 0, At, B0); PG8_MMA(0, 1, At, B1); PG8_BAR; PG8_SCHED;
            PG8_LDA(At, 1, 1); PG8_STAGE(PG8_SB(1, 0), b3, voffB); PG8_STAGE(PG8_SB(1, 1), b3 + hstep, voffB); PG8_STAGE(PG8_SA(1, 0), a3, voffA);
            PG8_WAIT_V(8); PG8_WAIT_L(0); PG8_BAR; PG8_MMA(1, 0, At, B0); PG8_MMA(1, 1, At, B1); PG8_BAR; PG8_SCHED;
            } else {
            PG8_LDB(B0, 0, 0); PG8_SCHED; PG8_LDA(At, 0, 0); PG8_STAGE(PG8_SA(1, 1), a1 + hstep, voffA);
            PG8_WAIT_L(8); PG8_BAR; PG8_WAIT_L(0); PG8_MMA(0, 0, At, B0); PG8_BAR; PG8_SCHED;
            PG8_LDB(B1, 0, 1); PG8_STAGE(PG8_SB(0, 0), b2, voffB);
            PG8_BAR; PG8_WAIT_L(0); PG8_MMA(0, 1, At, B1); PG8_BAR;
            PG8_LDA(At, 0, 1); PG8_STAGE(PG8_SA(0, 0), a2, voffA);
            PG8_BAR; PG8_WAIT_L(0); PG8_MMA(1, 0, At, B0); PG8_BAR; PG8_SCHED;
            PG8_STAGE(PG8_SB(0, 1), b2 + hstep, voffB);
            PG8_WAIT_V(6); PG8_BAR; PG8_MMA(1, 1, At, B1); PG8_BAR;
            PG8_LDB(B0, 1, 0); PG8_SCHED; PG8_LDA(At, 1, 0); PG8_STAGE(PG8_SA(0, 1), a2 + hstep, voffA);
            PG8_WAIT_L(8); PG8_BAR; PG8_WAIT_L(0); PG8_MMA(0, 0, At, B0); PG8_BAR; PG8_SCHED;
            PG8_LDB(B1, 1, 1); PG8_STAGE(PG8_SB(1, 0), b3, voffB);
            PG8_BAR; PG8_WAIT_L(0); PG8_MMA(0, 1, At, B1); PG8_BAR;
            PG8_LDA(At, 1, 1); PG8_STAGE(PG8_SA(1, 0), a3, voffA);
            PG8_BAR; PG8_WAIT_L(0); PG8_MMA(1, 0, At, B0); PG8_BAR; PG8_SCHED;
            PG8_STAGE(PG8_SB(1, 1), b3 + hstep, voffB);
            PG8_WAIT_V(6); PG8_BAR; PG8_MMA(1, 1, At, B1); PG8_BAR;
            }
        }
        if constexpr (ALIGN_EPI) { if (wr == 0) PG8_BAR; }
        if constexpr (!Epi::AFTER_DRAIN) { E(acc, cur, wr, wc, fr, fq); S.done(cur); }
        if (!has_next) break;
#pragma unroll
        for (int a = 0; a < 2; ++a)
#pragma unroll
            for (int b = 0; b < 2; ++b)
#pragma unroll
                for (int m = 0; m < 4; ++m)
#pragma unroll
                    for (int n = 0; n < 2; ++n) acc[a][b][m][n] = (f32x4){0.f, 0.f, 0.f, 0.f};
        cur = nxt; cA = nA; cB = nB; ++ui;
        if constexpr (ALIGN_EPI) { if (wr == 1) PG8_BAR; }
    }
    PG8_WAIT_V(0);
    if constexpr (!ALIGN_EPI) { if (wr == 0) PG8_BAR; }
    PG8_BAR;
    if constexpr (Epi::AFTER_DRAIN) { E.fused(acc, cur, wr, wc, fr, fq, lds, wid, lane); S.done(cur); }
#undef PG8_SA
#undef PG8_SB
#undef PG8_STAGE
#undef PG8_LDA
#undef PG8_LDB
#undef PG8_MMA
#undef PG8_WAIT_V
#undef PG8_WAIT_L
#undef PG8_BAR
#undef PG8_SCHED
}
}

#ifndef MK_N_LAUNCHES
#define MK_N_LAUNCHES 1
#endif
constexpr int DM = 1024, SEQ = 16384, NBATCH = 2, MP = NBATCH * SEQ, SBATCH = 32, STOK = 32, MS = SBATCH * STOK, MT = MP + MS;
constexpr int INW = 2560, DFF = 2816, PLE = 256, AW = 512, LW = 512, NHEAD = 8, HD = 64, KVL = 512, RELSZ = 192;
constexpr float EPS = 1e-6f;
constexpr float LOG2E = 1.4426950408889634f;
constexpr float QSCALE = 0.125f * LOG2E;
constexpr size_t OFF_Y = 0, OFF_NKP = (size_t)MT * DM, OFF_NVP = OFF_NKP + 524288, OFF_NCP = OFF_NVP + 524288, OFF_NHP = OFF_NCP + 3072,
                 OFF_NKS = OFF_NHP + 1024, OFF_NVS = OFF_NKS + 524288, OFF_NCS = OFF_NVS + 524288, OFF_NHS = OFF_NCS + 49152, OUT_TOTAL = OFF_NHS + 16384;
constexpr size_t al256(size_t x) { return (x + 255) & ~(size_t)255; }
constexpr size_t WS_WIN = 0;
constexpr size_t WS_WO  = WS_WIN + (size_t)INW * DM * 2;
constexpr size_t WS_WGU = WS_WO + (size_t)DM * DM * 2;
constexpr size_t WS_WD  = WS_WGU + (size_t)2 * DFF * DM * 2;
constexpr size_t WS_WPG = WS_WD + (size_t)DM * DFF * 2;
constexpr size_t WS_WPP = WS_WPG + (size_t)DM * DM * 2;
constexpr size_t WS_WRT = WS_WPP + (size_t)DM * PLE * 2;
constexpr size_t WS_WIT = WS_WRT + 8 * 64 * 64 * 2;
constexpr size_t WS_CTR = WS_WIT + 8 * 64 * 64 * 2;
constexpr size_t WS_BAR = WS_CTR + 4096;
constexpr size_t WS_AGG = WS_BAR + 16384;
constexpr size_t WS_SS1 = WS_AGG + (size_t)256 * 512 * 8;
constexpr size_t WS_SS2 = WS_SS1 + (size_t)MT * 16 * 4;
constexpr size_t WS_SSS2 = al256(WS_SS2 + (size_t)MT * 16 * 4);
constexpr size_t WS_XN  = al256(WS_SSS2 + (size_t)MS * 16 * 128);
constexpr size_t WS_PROJ = WS_XN + (size_t)MT * DM * 2;
constexpr size_t WS_VT  = WS_PROJ + (size_t)MT * DFF * 2;
constexpr size_t WS_KC  = WS_VT + (size_t)AW * MT * 2;
constexpr size_t WS_VTC = WS_KC + (size_t)SBATCH * KVL * AW * 2;
constexpr size_t WS_MIX = WS_VTC + (size_t)SBATCH * KVL * AW * 2;
constexpr size_t WS_Y12 = WS_MIX + (size_t)MT * DM * 2;
constexpr size_t WS_PB  = WS_Y12 + (size_t)MT * DM * 2;
constexpr size_t WS_END = WS_PB + (size_t)MT * PLE * 2;

constexpr int LDS_BYTES = 147456;

#define LAS __attribute__((address_space(3)))
typedef unsigned short bf16_t;
typedef short bf16x8 __attribute__((ext_vector_type(8)));
typedef float f32x4 __attribute__((ext_vector_type(4)));
typedef float f32x2 __attribute__((ext_vector_type(2)));
typedef unsigned u32x4 __attribute__((ext_vector_type(4)));
typedef unsigned u32x2 __attribute__((ext_vector_type(2)));
#define LDS_FENCE() asm volatile("s_waitcnt lgkmcnt(0)" ::: "memory")

typedef float f32x2_t __attribute__((ext_vector_type(2))); typedef __bf16 bf16x2_t __attribute__((ext_vector_type(2)));
__device__ __forceinline__ unsigned pk2(float lo, float hi) { const f32x2_t v = {lo, hi}; const bf16x2_t b = __builtin_convertvector(v, bf16x2_t); return __builtin_bit_cast(unsigned, b); }
__device__ __forceinline__ float bf2f(unsigned short b) { return __uint_as_float((unsigned)b << 16); }
__device__ __forceinline__ float wave_sum(float v) {
#pragma unroll
    for (int o = 1; o < 64; o <<= 1) v += __shfl_xor(v, o);
    return v;
}
__device__ __forceinline__ float fast_exp2(float x) { return __builtin_amdgcn_exp2f(x); }
__device__ __forceinline__ float fast_rcp(float x) { return __builtin_amdgcn_rcpf(x); }
__device__ __forceinline__ float sigmoid_f(float x) { return fast_rcp(1.f + fast_exp2(-x * LOG2E)); }

__device__ __forceinline__ float srow_rs(const float* sss, int r);
namespace pg8 {
struct EpiInProj {
    static constexpr bool PERM = true, AFTER_DRAIN = false;
    bf16_t* proj; bf16_t* vt; float* out;
    __device__ __forceinline__ void operator()(const f32x4 (&acc)[2][2][4][2], const Unit& u, int wr, int wc, int fr, int fq) const {
        const int pm = u.pm, pn = u.pn;
        const bool kvtail = (pm >= 128) || ((pm & 63) >= 62);
        const float sc = (pn < 2) ? QSCALE : 1.f;
#pragma unroll
        for (int ai = 0; ai < 2; ++ai)
#pragma unroll
            for (int m = 0; m < 4; ++m) {
                const int row = pm * BM + ai * HALF + wr * 64 + m * 16 + fr;
#pragma unroll
                for (int bj = 0; bj < 2; ++bj) {
                    const int col = pn * BM + bj * HALF + wc * 32 + 8 * fq;
                    const f32x4 v0 = acc[ai][bj][m][0] * sc, v1 = acc[ai][bj][m][1] * sc;
                    if (pn == 4 || pn == 5) {
                        const int hd = col - 1024;
                        bf16_t* vp = vt + (size_t)hd * MT + row;
#pragma unroll
                        for (int i = 0; i < 4; ++i) { vp[(size_t)i * MT] = (bf16_t)(pk2(v0[i], 0.f) & 0xffffu); vp[(size_t)(4 + i) * MT] = (bf16_t)(pk2(v1[i], 0.f) & 0xffffu); }
                    } else {
                        u32x4 w; w.x = pk2(v0[0], v0[1]); w.y = pk2(v0[2], v0[3]); w.z = pk2(v1[0], v1[1]); w.w = pk2(v1[2], v1[3]);
                        *(u32x4*)(proj + (size_t)row * INW + col) = w;
                    }
                    if (pn >= 2 && pn <= 5 && kvtail) {
                        const int c = col - (pn < 4 ? 512 : 1024);
                        float* dst;
                        if (row < MP) { const int b = row >> 14, s = row & (SEQ - 1); dst = out + (pn < 4 ? OFF_NKP : OFF_NVP) + (size_t)(b * 512 + (s - (SEQ - 512))) * 512 + c; }
                        else dst = out + (pn < 4 ? OFF_NKS : OFF_NVS) + (size_t)(row - MP) * 512 + c;
                        *(f32x4*)dst = v0; *(f32x4*)(dst + 4) = v1;
                    }
                    if (pn == 6 || pn == 7) {
                        const int c = col - 1536;
                        if (row < MP) { const int s = row & (SEQ - 1); if (s >= SEQ - 3) { float* dst = out + OFF_NCP + (size_t)((row >> 14) * 3 + (s - (SEQ - 3))) * 512 + c; *(f32x4*)dst = v0; *(f32x4*)(dst + 4) = v1; } }
                        else { const int t = (row - MP) & 31; if (t >= 29) { float* dst = out + OFF_NCS + (size_t)(((row - MP) >> 5) * 3 + (t - 29)) * 512 + c; *(f32x4*)dst = v0; *(f32x4*)(dst + 4) = v1; } }
                    }
                }
            }
    }
};
template <bool F32BASE> struct EpiResid {
    static constexpr bool PERM = true, AFTER_DRAIN = false;
    const float* base_p; const float* base_s; bf16_t* hb; float* ss;
    __device__ __forceinline__ void operator()(const f32x4 (&acc)[2][2][4][2], const Unit& u, int wr, int wc, int fr, int fq) const {
        const int col0 = u.pn * BM + wc * 32 + 8 * fq;
#pragma unroll
        for (int ai = 0; ai < 2; ++ai)
#pragma unroll
            for (int m = 0; m < 4; ++m) {
                const int r = u.pm * BM + ai * HALF + wr * 64 + m * 16 + fr;
                float s = 0.f;
#pragma unroll
                for (int bj = 0; bj < 2; ++bj) {
                    const int c = col0 + bj * HALF;
                    f32x4 v0, v1;
                    if (F32BASE) { const float* brow = (r < MP) ? base_p + (size_t)r * DM : base_s + (size_t)(r - MP) * DM; v0 = *(const f32x4*)(brow + c); v1 = *(const f32x4*)(brow + c + 4); }
                    else { const u32x4 w = *(const u32x4*)(hb + (size_t)r * DM + c);
                        v0 = (f32x4){__uint_as_float(w.x << 16), __uint_as_float(w.x & 0xffff0000u), __uint_as_float(w.y << 16), __uint_as_float(w.y & 0xffff0000u)};
                        v1 = (f32x4){__uint_as_float(w.z << 16), __uint_as_float(w.z & 0xffff0000u), __uint_as_float(w.w << 16), __uint_as_float(w.w & 0xffff0000u)}; }
                    v0 = v0 + acc[ai][bj][m][0]; v1 = v1 + acc[ai][bj][m][1];
                    s += ((v0[0] * v0[0] + v0[1] * v0[1]) + (v0[2] * v0[2] + v0[3] * v0[3])) + ((v1[0] * v1[0] + v1[1] * v1[1]) + (v1[2] * v1[2] + v1[3] * v1[3]));
                    u32x4 o; o.x = pk2(v0[0], v0[1]); o.y = pk2(v0[2], v0[3]); o.z = pk2(v1[0], v1[1]); o.w = pk2(v1[2], v1[3]);
                    *(u32x4*)(hb + (size_t)r * DM + c) = o;
                }
                s += __shfl_xor(s, 16); s += __shfl_xor(s, 32);
                if (fq == 0) ss[(size_t)r * 16 + u.pn * 4 + wc] = s;
            }
    }
};
__device__ __forceinline__ float row_rs(const float* ss, int r) {
    const f32x4* p = (const f32x4*)(ss + (size_t)r * 16);
    const f32x4 a = p[0], b = p[1], c = p[2], d = p[3];
    const float t = ((a[0] + a[1]) + (a[2] + a[3])) + ((b[0] + b[1]) + (b[2] + b[3])) + ((c[0] + c[1]) + (c[2] + c[3])) + ((d[0] + d[1]) + (d[2] + d[3]));
    return __builtin_amdgcn_rsqf(t * (1.f / DM) + EPS);
}
struct EpiSwiglu {
    static constexpr bool PERM = true, AFTER_DRAIN = false;
    const float* ss; bf16_t* act;
    __device__ __forceinline__ void operator()(const f32x4 (&acc)[2][2][4][2], const Unit& u, int wr, int wc, int fr, int fq) const {
        const int f0 = u.pn * HALF + wc * 32 + 8 * fq;
#pragma unroll
        for (int ai = 0; ai < 2; ++ai)
#pragma unroll
            for (int m = 0; m < 4; ++m) {
                const int r = u.pm * BM + ai * HALF + wr * 64 + m * 16 + fr;
                const float rs = row_rs(ss, r);
                float o[8];
#pragma unroll
                for (int n = 0; n < 2; ++n)
#pragma unroll
                    for (int i = 0; i < 4; ++i) { const float g = acc[ai][0][m][n][i] * rs, up = acc[ai][1][m][n][i] * rs; o[n * 4 + i] = g * sigmoid_f(g) * up; }
                u32x4 w; w.x = pk2(o[0], o[1]); w.y = pk2(o[2], o[3]); w.z = pk2(o[4], o[5]); w.w = pk2(o[6], o[7]);
                *(u32x4*)(act + (size_t)r * DFF + f0) = w;
            }
    }
};
struct EpiStoreBf16 {
    static constexpr bool PERM = true, AFTER_DRAIN = false;
    bf16_t* o;
    __device__ __forceinline__ void operator()(const f32x4 (&acc)[2][2][4][2], const Unit& u, int wr, int wc, int fr, int fq) const {
#pragma unroll
        for (int ai = 0; ai < 2; ++ai)
#pragma unroll
            for (int m = 0; m < 4; ++m) {
                const int r = u.pm * BM + ai * HALF + wr * 64 + m * 16 + fr;
#pragma unroll
                for (int bj = 0; bj < 2; ++bj) {
                    const int c = u.pn * BM + bj * HALF + wc * 32 + 8 * fq;
                    const f32x4 v0 = acc[ai][bj][m][0], v1 = acc[ai][bj][m][1];
                    u32x4 w; w.x = pk2(v0[0], v0[1]); w.y = pk2(v0[2], v0[3]); w.z = pk2(v1[0], v1[1]); w.w = pk2(v1[2], v1[3]);
                    *(u32x4*)(o + (size_t)r * DM + c) = w;
                }
            }
    }
};
struct EpiPleGate {
    static constexpr bool PERM = true, AFTER_DRAIN = false;
    const float* ss; const float* sss; const bf16_t* pp; const bf16_t* h2; bf16_t* h3;
    __device__ __forceinline__ void operator()(const f32x4 (&acc)[2][2][4][2], const Unit& u, int wr, int wc, int fr, int fq) const {
        const int col0 = u.pn * BM + wc * 32 + 8 * fq;
#pragma unroll
        for (int ai = 0; ai < 2; ++ai)
#pragma unroll
            for (int m = 0; m < 4; ++m) {
                const int r = u.pm * BM + ai * HALF + wr * 64 + m * 16 + fr;
                float rs; if (u.pm < MP / BM) rs = row_rs(ss, r); else rs = srow_rs(sss, r);
#pragma unroll
                for (int bj = 0; bj < 2; ++bj) {
                    const int c = col0 + bj * HALF;
                    const u32x4 pw = *(const u32x4*)(pp + (size_t)r * DM + c), hw = *(const u32x4*)(h2 + (size_t)r * DM + c);
                    const f32x4 a0 = acc[ai][bj][m][0], a1 = acc[ai][bj][m][1];
                    float o[8];
                    o[0] = __uint_as_float(hw.x << 16) + __uint_as_float(pw.x << 16) * sigmoid_f(a0[0] * rs); o[1] = __uint_as_float(hw.x & 0xffff0000u) + __uint_as_float(pw.x & 0xffff0000u) * sigmoid_f(a0[1] * rs);
                    o[2] = __uint_as_float(hw.y << 16) + __uint_as_float(pw.y << 16) * sigmoid_f(a0[2] * rs); o[3] = __uint_as_float(hw.y & 0xffff0000u) + __uint_as_float(pw.y & 0xffff0000u) * sigmoid_f(a0[3] * rs);
                    o[4] = __uint_as_float(hw.z << 16) + __uint_as_float(pw.z << 16) * sigmoid_f(a1[0] * rs); o[5] = __uint_as_float(hw.z & 0xffff0000u) + __uint_as_float(pw.z & 0xffff0000u) * sigmoid_f(a1[1] * rs);
                    o[6] = __uint_as_float(hw.w << 16) + __uint_as_float(pw.w << 16) * sigmoid_f(a1[2] * rs); o[7] = __uint_as_float(hw.w & 0xffff0000u) + __uint_as_float(pw.w & 0xffff0000u) * sigmoid_f(a1[3] * rs);
                    u32x4 w; w.x = pk2(o[0], o[1]); w.y = pk2(o[2], o[3]); w.z = pk2(o[4], o[5]); w.w = pk2(o[6], o[7]);
                    *(u32x4*)(h3 + (size_t)r * DM + c) = w;
                }
            }
    }
};
}

struct Params { const float* in[29]; float* out; unsigned char* ws; int ph_lo, ph_hi; };
enum { I_XP = 0, I_XS, I_PP, I_PS, I_CK, I_CV, I_SCONV, I_SH, I_GMIX, I_WIN, I_CONVW, I_CONVB, I_WR, I_BR, I_WI, I_BI, I_LAMBDA, I_REL, I_GATT, I_GLRU, I_WOUT, I_GFFN,
       I_WG, I_WU, I_WD, I_GPLE, I_WPG, I_WPP, I_GFINAL };

__device__ __forceinline__ void p0_transpose_item(const float* W, int N, bf16_t* WT, int ldk, int drow0, const float* g, LAS float* scr, int k0, int n0, int lane) {
#pragma unroll 8
    for (int i = 0; i < 32; ++i) { const int kk = 2 * i + (lane >> 5); float v = W[(size_t)(k0 + kk) * N + n0 + (lane & 31)]; if (g) v *= g[k0 + kk]; scr[kk * 33 + (lane & 31)] = v; }
    LDS_FENCE();
    const int c = lane & 7;
#pragma unroll
    for (int j = 0; j < 4; ++j) { const int n = (lane >> 3) + 8 * j; const LAS float* s = scr + (8 * c) * 33 + n;
        u32x4 o; o.x = pk2(s[0 * 33], s[1 * 33]); o.y = pk2(s[2 * 33], s[3 * 33]); o.z = pk2(s[4 * 33], s[5 * 33]); o.w = pk2(s[6 * 33], s[7 * 33]);
        *(u32x4*)(WT + (size_t)(drow0 + n) * ldk + k0 + 8 * c) = o; }
    LDS_FENCE();
}

__device__ __forceinline__ void p0_prologue(const Params& p, LAS unsigned char* lds, int wave, int lane, int part, int gw, int NGW) {
    unsigned char* ws = p.ws;
    LAS float* scr = (LAS float*)(lds + wave * 16384);
    constexpr int T_WIN = 16 * 80, T_WO = 16 * 32, T_WG = 16 * 88, T_WU = T_WG, T_WD = 44 * 32, T_WPG = 16 * 32, T_WPP = 4 * 32, T_GR = 8 * 2, T_GI = 8 * 2, T_CV = 32 * 8 * 16;
    constexpr int NT = T_WIN + T_WO + T_WG + T_WU + T_WD + T_WPG + T_WPP + T_GR + T_GI + T_CV;
    constexpr int D_LO = T_WIN + T_WO, D_HI = D_LO + T_WG + T_WU + T_WD + T_WPG;
    const int n_it = part ? (D_HI - D_LO) : NT - (D_HI - D_LO);
    for (int ii = gw; ii < n_it; ii += NGW) {
        const int it = part ? D_LO + ii : (ii < D_LO ? ii : ii + (D_HI - D_LO));
        int r = it;
        if (r < T_WIN) { p0_transpose_item(p.in[I_WIN], INW, (bf16_t*)(ws + WS_WIN), DM, (r % 80) * 32, nullptr, scr, (r / 80) * 64, (r % 80) * 32, lane); continue; } r -= T_WIN;
        if (r < T_WO)  { p0_transpose_item(p.in[I_WOUT], DM, (bf16_t*)(ws + WS_WO), DM, (r % 32) * 32, nullptr, scr, (r / 32) * 64, (r % 32) * 32, lane); continue; } r -= T_WO;
        if (r < T_WG)  { const int n0 = (r % 88) * 32; p0_transpose_item(p.in[I_WG], DFF, (bf16_t*)(ws + WS_WGU), DM, 256 * (n0 / 128) + (n0 % 128), p.in[I_GFFN], scr, (r / 88) * 64, n0, lane); continue; } r -= T_WG;
        if (r < T_WU)  { const int n0 = (r % 88) * 32; p0_transpose_item(p.in[I_WU], DFF, (bf16_t*)(ws + WS_WGU), DM, 256 * (n0 / 128) + 128 + (n0 % 128), p.in[I_GFFN], scr, (r / 88) * 64, n0, lane); continue; } r -= T_WU;
        if (r < T_WD)  { p0_transpose_item(p.in[I_WD], DM, (bf16_t*)(ws + WS_WD), DFF, (r % 32) * 32, nullptr, scr, (r / 32) * 64, (r % 32) * 32, lane); continue; } r -= T_WD;
        if (r < T_WPG) { p0_transpose_item(p.in[I_WPG], DM, (bf16_t*)(ws + WS_WPG), DM, (r % 32) * 32, p.in[I_GPLE], scr, (r / 32) * 64, (r % 32) * 32, lane); continue; } r -= T_WPG;
        if (r < T_WPP) { p0_transpose_item(p.in[I_WPP], DM, (bf16_t*)(ws + WS_WPP), PLE, (r % 32) * 32, nullptr, scr, (r / 32) * 64, (r % 32) * 32, lane); continue; } r -= T_WPP;
        if (r < T_GR)  { const int n = r >> 1; p0_transpose_item(p.in[I_WR] + n * 4096, 64, (bf16_t*)(ws + WS_WRT) + n * 4096, 64, (r & 1) * 32, nullptr, scr, 0, (r & 1) * 32, lane); continue; } r -= T_GR;
        if (r < T_GI)  { const int n = r >> 1; p0_transpose_item(p.in[I_WI] + n * 4096, 64, (bf16_t*)(ws + WS_WIT) + n * 4096, 64, (r & 1) * 32, nullptr, scr, 0, (r & 1) * 32, lane); continue; } r -= T_GI;
        { const int b = r >> 7, q = r & 127; p0_transpose_item(p.in[I_CV] + (size_t)b * KVL * AW, AW, (bf16_t*)(ws + WS_VTC) + (size_t)b * AW * KVL, KVL, (q & 15) * 32, nullptr, scr, (q >> 4) * 64, (q & 15) * 32, lane); }
    }
    if (part) return;
    bf16_t* XN = (bf16_t*)(ws + WS_XN); bf16_t* PB = (bf16_t*)(ws + WS_PB);
    const f32x4* gm = (const f32x4*)p.in[I_GMIX];
    for (int m = gw; m < MT; m += NGW) {
        const float* xrow = (m < MP) ? p.in[I_XP] + (size_t)m * DM : p.in[I_XS] + (size_t)(m - MP) * DM;
        const f32x4* xr = (const f32x4*)xrow + lane;
        f32x4 v[4]; float s = 0.f;
#pragma unroll
        for (int j = 0; j < 4; ++j) { v[j] = xr[64 * j]; s += (v[j][0] * v[j][0] + v[j][1] * v[j][1]) + (v[j][2] * v[j][2] + v[j][3] * v[j][3]); }
        const float rs = __builtin_amdgcn_rsqf(wave_sum(s) * (1.f / DM) + EPS);
        u32x2* o8 = (u32x2*)(XN + (size_t)m * DM) + lane;
#pragma unroll
        for (int j = 0; j < 4; ++j) { const f32x4 g = gm[lane + 64 * j]; u32x2 w; w.x = pk2(v[j][0] * rs * g[0], v[j][1] * rs * g[1]); w.y = pk2(v[j][2] * rs * g[2], v[j][3] * rs * g[3]); o8[64 * j] = w; }
        const float* prow = (m < MP) ? p.in[I_PP] + (size_t)m * PLE : p.in[I_PS] + (size_t)(m - MP) * PLE;
        const f32x4 pv = ((const f32x4*)prow)[lane];
        u32x2 w; w.x = pk2(pv[0], pv[1]); w.y = pk2(pv[2], pv[3]);
        ((u32x2*)(PB + (size_t)m * PLE))[lane] = w;
    }
    bf16_t* KC = (bf16_t*)(ws + WS_KC);
    constexpr int NKC = SBATCH * KVL * AW / 512;
    for (int it = gw; it < NKC; it += NGW) {
        const f32x4* src = (const f32x4*)(p.in[I_CK] + (size_t)it * 512) + 2 * lane;
        const f32x4 a = src[0], b = src[1];
        u32x4 w; w.x = pk2(a[0], a[1]); w.y = pk2(a[2], a[3]); w.z = pk2(b[0], b[1]); w.w = pk2(b[2], b[3]);
        ((u32x4*)(KC + (size_t)it * 512))[lane] = w;
    }
}

template <int MQ>
__device__ __forceinline__ void attn_item(const Params& p, LAS unsigned char* lds, int wave, int lane, bool sample, int ib, int ic) {
    unsigned char* ws = p.ws;
    const bf16_t* proj = (const bf16_t*)(ws + WS_PROJ); const bf16_t* vt = (const bf16_t*)(ws + WS_VT);
    const bf16_t* kc = (const bf16_t*)(ws + WS_KC); const bf16_t* vtc = (const bf16_t*)(ws + WS_VTC);
    bf16_t* mix = (bf16_t*)(ws + WS_MIX);
    LAS float* tab = (LAS float*)lds;
    LAS float* ssq = (LAS float*)(lds + 8192);
    const int fr = lane & 15, fq = lane >> 4, h = wave;
    const int qrow0 = sample ? MP + STOK * ib : ib * SEQ + 64 * ic;
    bf16x8 qf[MQ][2];
    { const bf16_t* qp = proj + (size_t)(qrow0 + fr) * INW + h * HD + 8 * fq;
#pragma unroll
      for (int qt = 0; qt < MQ; ++qt)
#pragma unroll
          for (int ks = 0; ks < 2; ++ks) qf[qt][ks] = *(const bf16x8*)(qp + (size_t)qt * 16 * INW + 32 * ks); }
    f32x4 o[4][MQ];
    float mref[MQ], lsum[MQ];
#pragma unroll
    for (int qt = 0; qt < MQ; ++qt) { mref[qt] = -1e30f; lsum[qt] = 0.f;
#pragma unroll
        for (int dt = 0; dt < 4; ++dt) o[dt][qt] = (f32x4){0.f, 0.f, 0.f, 0.f}; }
    const int kperm = 8 * (fr >> 2) + (fr & 3);
    const bool uni = !sample && ic < 8;
    const int t0 = sample ? 0 : (ic < 8 ? 2 * (8 - ic) : (ic < 16 ? 2 * (16 - ic) : 0)), nt = sample ? 17 : 18;
    const LAS float* tb = tab + h * RELSZ;
#define ATT_TILE_PTRS(T, KP, KST, VP, VST, KPOS0) do { \
        if (sample && (T) < 16) { KP = kc + ((size_t)(ib * KVL + 32 * (T))) * AW + h * HD; KST = AW; VP = vtc + ((size_t)(ib * AW + h * HD)) * KVL + 32 * (T); VST = KVL; KPOS0 = -KVL + 32 * (T); } \
        else { int krow0_; if (sample) { krow0_ = qrow0; KPOS0 = 0; } else { const int dl_ = -8 + ((T) >> 1); krow0_ = ib * SEQ + 64 * (ic + dl_) + 32 * ((T) & 1); KPOS0 = 64 * dl_ + 32 * ((T) & 1); } \
            KP = proj + (size_t)krow0_ * INW + 512 + h * HD; KST = INW; VP = vt + (size_t)(h * HD) * MT + krow0_; VST = MT; } } while (0)
    bf16x8 kf[2][2];
    { const bf16_t* kp; const bf16_t* vp; size_t kst, vst; int kpos0; ATT_TILE_PTRS(t0, kp, kst, vp, vst, kpos0); (void)vp; (void)vst; (void)kpos0;
#pragma unroll
      for (int kt = 0; kt < 2; ++kt)
#pragma unroll
          for (int ks = 0; ks < 2; ++ks) kf[kt][ks] = *(const bf16x8*)(kp + (size_t)(kperm + 4 * kt) * kst + 32 * ks + 8 * fq); }
    for (int t = t0; t < nt; ++t) {
        const bf16_t* kp; const bf16_t* vp; size_t kst, vst; int kpos0;
        ATT_TILE_PTRS(t, kp, kst, vp, vst, kpos0);
        bf16x8 vf[4], kn[2][2];
#pragma unroll
        for (int dt = 0; dt < 4; ++dt) vf[dt] = *(const bf16x8*)(vp + (size_t)(dt * 16 + fr) * vst + 8 * fq);
        { const int tn = (t + 1 < nt) ? t + 1 : t; const bf16_t* kp2; const bf16_t* vp2; size_t kst2, vst2; int kpos2; ATT_TILE_PTRS(tn, kp2, kst2, vp2, vst2, kpos2); (void)vp2; (void)vst2; (void)kpos2;
#pragma unroll
          for (int kt = 0; kt < 2; ++kt)
#pragma unroll
              for (int ks = 0; ks < 2; ++ks) kn[kt][ks] = *(const bf16x8*)(kp2 + (size_t)(kperm + 4 * kt) * kst2 + 32 * ks + 8 * fq); }
        (void)kp; (void)kst;
        bf16x8 pf[MQ];
        if (uni) {
#pragma unroll
            for (int qt = 0; qt < MQ; ++qt) pf[qt] = __builtin_bit_cast(bf16x8, (u32x4){0x3F803F80u, 0x3F803F80u, 0x3F803F80u, 0x3F803F80u});
        } else {
        f32x4 s[2][MQ];
#pragma unroll
        for (int kt = 0; kt < 2; ++kt)
#pragma unroll
            for (int qt = 0; qt < MQ; ++qt) {
                s[kt][qt] = __builtin_amdgcn_mfma_f32_16x16x32_bf16(kf[kt][0], qf[qt][0], (f32x4){0.f, 0.f, 0.f, 0.f}, 0, 0, 0);
                s[kt][qt] = __builtin_amdgcn_mfma_f32_16x16x32_bf16(kf[kt][1], qf[qt][1], s[kt][qt], 0, 0, 0);
            }
        if (kpos0 <= -160) {
            const float b0 = tb[0];
#pragma unroll
            for (int kt = 0; kt < 2; ++kt)
#pragma unroll
                for (int qt = 0; qt < MQ; ++qt) s[kt][qt] = s[kt][qt] + b0;
        } else {
#pragma unroll
            for (int kt = 0; kt < 2; ++kt)
#pragma unroll
                for (int qt = 0; qt < MQ; ++qt)
#pragma unroll
                    for (int i = 0; i < 4; ++i) {
                        int rel = kpos0 + 8 * fq + 4 * kt + i - (qt * 16 + fr);
                        rel = rel < -128 ? -128 : (rel > 63 ? 63 : rel);
                        s[kt][qt][i] += tb[rel + 128];
                    }
        }
        bool need = false; float lm[MQ];
#pragma unroll
        for (int qt = 0; qt < MQ; ++qt) {
            float a = fmaxf(fmaxf(s[0][qt][0], s[0][qt][1]), fmaxf(s[0][qt][2], s[0][qt][3]));
            float b = fmaxf(fmaxf(s[1][qt][0], s[1][qt][1]), fmaxf(s[1][qt][2], s[1][qt][3]));
            lm[qt] = fmaxf(a, b); need = need || (lm[qt] > mref[qt] + 8.f);
        }
        if (__any(need)) {
#pragma unroll
            for (int qt = 0; qt < MQ; ++qt) {
                float rm = lm[qt]; rm = fmaxf(rm, __shfl_xor(rm, 16)); rm = fmaxf(rm, __shfl_xor(rm, 32));
                const float mn = fmaxf(mref[qt], rm), al = fast_exp2(mref[qt] - mn);
                mref[qt] = mn; lsum[qt] *= al;
#pragma unroll
                for (int dt = 0; dt < 4; ++dt) o[dt][qt] = o[dt][qt] * al;
            }
        }
#pragma unroll
        for (int qt = 0; qt < MQ; ++qt) {
            float e[8];
#pragma unroll
            for (int i = 0; i < 4; ++i) { e[i] = fast_exp2(s[0][qt][i] - mref[qt]); e[4 + i] = fast_exp2(s[1][qt][i] - mref[qt]); }
            lsum[qt] += ((e[0] + e[1]) + (e[2] + e[3])) + ((e[4] + e[5]) + (e[6] + e[7]));
            u32x4 w; w.x = pk2(e[0], e[1]); w.y = pk2(e[2], e[3]); w.z = pk2(e[4], e[5]); w.w = pk2(e[6], e[7]);
            pf[qt] = __builtin_bit_cast(bf16x8, w);
        }
        }
#pragma unroll
        for (int dt = 0; dt < 4; ++dt)
#pragma unroll
            for (int qt = 0; qt < MQ; ++qt) o[dt][qt] = __builtin_amdgcn_mfma_f32_16x16x32_bf16(vf[dt], pf[qt], o[dt][qt], 0, 0, 0);
#pragma unroll
        for (int kt = 0; kt < 2; ++kt)
#pragma unroll
            for (int ks = 0; ks < 2; ++ks) kf[kt][ks] = kn[kt][ks];
    }
#undef ATT_TILE_PTRS
#pragma unroll
    for (int qt = 0; qt < MQ; ++qt) {
        float l = lsum[qt]; l += __shfl_xor(l, 16); l += __shfl_xor(l, 32);
        const float inv = uni ? (1.f / 576.f) : 1.f / l; float sq = 0.f;
#pragma unroll
        for (int dt = 0; dt < 4; ++dt) { o[dt][qt] = o[dt][qt] * inv; const f32x4 v = o[dt][qt]; sq += (v[0] * v[0] + v[1] * v[1]) + (v[2] * v[2] + v[3] * v[3]); }
        sq += __shfl_xor(sq, 16); sq += __shfl_xor(sq, 32);
        if (fq == 0) ssq[h * 64 + qt * 16 + fr] = sq;
    }
    __syncthreads();
    const float* ga = p.in[I_GATT] + h * HD + 4 * fq;
#pragma unroll
    for (int qt = 0; qt < MQ; ++qt) {
        float tot = 0.f;
#pragma unroll
        for (int hh = 0; hh < 8; ++hh) tot += ssq[hh * 64 + qt * 16 + fr];
        const float rs = __builtin_amdgcn_rsqf(tot * (1.f / AW) + EPS);
        bf16_t* mp = mix + (size_t)(qrow0 + qt * 16 + fr) * DM + h * HD + 4 * fq;
#pragma unroll
        for (int dt = 0; dt < 4; ++dt) {
            const f32x4 g = *(const f32x4*)(ga + dt * 16); const f32x4 v = o[dt][qt] * rs;
            u32x2 w; w.x = pk2(v[0] * g[0], v[1] * g[1]); w.y = pk2(v[2] * g[2], v[3] * g[3]);
            *(u32x2*)(mp + dt * 16) = w;
        }
    }
    __syncthreads();
}

__device__ __forceinline__ float gelu_tanh(float x) { const float z = 0.7978845608028654f * (x + 0.044715f * x * x * x); return x * fast_rcp(1.f + fast_exp2(-2.f * LOG2E * z)); }
__device__ __forceinline__ void lru_queue(const Params& p, LAS unsigned char* lds, int wave, int lane, unsigned* qctr, int n_items) {
    unsigned char* ws = p.ws;
    const bf16_t* proj = (const bf16_t*)(ws + WS_PROJ);
    bf16_t* Y1 = (bf16_t*)(ws + WS_Y12); bf16_t* Y2 = Y1 + (size_t)MT * LW;
    LAS bf16_t* xcs = (LAS bf16_t*)(lds + 16384 + wave * 12288);
    LAS f32x2* ag = (LAS f32x2*)(lds + 16384 + wave * 12288 + 4096);
    const int fr = lane & 15, fq = lane >> 4, n = wave, c = n * 64 + lane;
    bf16x8 wrf[4][2], wif[4][2];
    { const bf16_t* wr = (const bf16_t*)(ws + WS_WRT) + n * 4096; const bf16_t* wi = (const bf16_t*)(ws + WS_WIT) + n * 4096;
#pragma unroll
      for (int jt = 0; jt < 4; ++jt)
#pragma unroll
          for (int ks = 0; ks < 2; ++ks) { wrf[jt][ks] = *(const bf16x8*)(wr + (jt * 16 + fr) * 64 + 32 * ks + 8 * fq); wif[jt][ks] = *(const bf16x8*)(wi + (jt * 16 + fr) * 64 + 32 * ks + 8 * fq); } }
    float br[4], bi[4], sp8[4];
#pragma unroll
    for (int jt = 0; jt < 4; ++jt) { const int ch = n * 64 + jt * 16 + fr; br[jt] = p.in[I_BR][ch]; bi[jt] = p.in[I_BI][ch];
        const float L = p.in[I_LAMBDA][ch]; sp8[jt] = 8.f * LOG2E * (fmaxf(-L, 0.f) + log1pf(__expf(-fabsf(L)))); }
    const float cw0 = p.in[I_CONVW][c], cw1 = p.in[I_CONVW][512 + c], cw2 = p.in[I_CONVW][1024 + c], cw3 = p.in[I_CONVW][1536 + c], cb = p.in[I_CONVB][c];
    volatile LAS int* qslot = (volatile LAS int*)(lds + 12288);
    const int tid = wave * 64 + lane;
    for (;;) {
    if (tid == 0) qslot[0] = (int)__hip_atomic_fetch_add(qctr, 1u, __ATOMIC_RELAXED, __HIP_MEMORY_SCOPE_AGENT);
    __syncthreads(); const int tile = qslot[0]; __syncthreads();
    if (tile >= n_items) break;
    const bool sample = tile >= 128;
    const int row0 = sample ? MP + STOK * (tile - 128) : tile * 256;
    const int nsub = sample ? 2 : 16;
    float xm3, xm2, xm1, h, P = 1.f;
    if (sample) { const float* sc = p.in[I_SCONV] + (size_t)(tile - 128) * 3 * LW + c; xm3 = sc[0]; xm2 = sc[LW]; xm1 = sc[2 * LW]; h = p.in[I_SH][(tile - 128) * LW + c]; }
    else if ((tile & 63) == 0) { xm3 = xm2 = xm1 = 0.f; h = 0.f; }
    else { const bf16_t* xp = proj + (size_t)(row0 - 3) * INW + 1536 + c; xm3 = bf2f(xp[0]); xm2 = bf2f(xp[INW]); xm1 = bf2f(xp[2 * INW]); h = 0.f; }
    bf16_t xr_[16], gr_[16];
    { const bf16_t* xp = proj + (size_t)row0 * INW + 1536 + c;
#pragma unroll
      for (int t = 0; t < 16; ++t) { xr_[t] = xp[(size_t)t * INW]; gr_[t] = xp[(size_t)t * INW + 512]; } }
    for (int sub = 0; sub < nsub; ++sub) {
        const int r0 = row0 + sub * 16;
        bf16_t xn_[16], gn_[16];
        { const bf16_t* xp = proj + (size_t)(row0 + (sub + 1 < nsub ? sub + 1 : sub) * 16) * INW + 1536 + c;
#pragma unroll
          for (int t = 0; t < 16; ++t) { xn_[t] = xp[(size_t)t * INW]; gn_[t] = xp[(size_t)t * INW + 512]; } }
        float xc[16], ge[16];
#pragma unroll
        for (int t = 0; t < 16; ++t) { const float xv = bf2f(xr_[t]); ge[t] = gelu_tanh(bf2f(gr_[t]));
            xc[t] = cb + cw0 * xm3 + cw1 * xm2 + cw2 * xm1 + cw3 * xv; xm3 = xm2; xm2 = xm1; xm1 = xv;
            xcs[t * 72 + lane] = (bf16_t)(pk2(xc[t], 0.f) & 0xffffu); }
#pragma unroll
        for (int t = 0; t < 16; ++t) { xr_[t] = xn_[t]; gr_[t] = gn_[t]; }
        LDS_FENCE();
        bf16x8 xa[2];
#pragma unroll
        for (int ks = 0; ks < 2; ++ks) xa[ks] = *(const LAS bf16x8*)(xcs + fr * 72 + 32 * ks + 8 * fq);
#pragma unroll
        for (int jt = 0; jt < 4; ++jt) {
            f32x4 pr = __builtin_amdgcn_mfma_f32_16x16x32_bf16(xa[0], wrf[jt][0], (f32x4){0.f, 0.f, 0.f, 0.f}, 0, 0, 0);
            pr = __builtin_amdgcn_mfma_f32_16x16x32_bf16(xa[1], wrf[jt][1], pr, 0, 0, 0);
            f32x4 pi = __builtin_amdgcn_mfma_f32_16x16x32_bf16(xa[0], wif[jt][0], (f32x4){0.f, 0.f, 0.f, 0.f}, 0, 0, 0);
            pi = __builtin_amdgcn_mfma_f32_16x16x32_bf16(xa[1], wif[jt][1], pi, 0, 0, 0);
#pragma unroll
            for (int i = 0; i < 4; ++i) {
                const float r = sigmoid_f(pr[i] + br[jt]), ig = sigmoid_f(pi[i] + bi[jt]);
                const float a = fast_exp2(-r * sp8[jt]), mlt = __builtin_amdgcn_sqrtf(fmaxf(1.f - a * a, 0.f)) * ig;
                ag[(4 * fq + i) * 64 + jt * 16 + fr] = (f32x2){a, mlt};
            }
        }
        LDS_FENCE();
        bf16_t* y1p = Y1 + (size_t)r0 * LW + c; bf16_t* y2p = Y2 + (size_t)r0 * LW + c;
#pragma unroll
        for (int t = 0; t < 16; ++t) {
            const f32x2 am = ag[t * 64 + lane];
            h = am.x * h + am.y * xc[t]; P *= am.x;
            y1p[(size_t)t * LW] = (bf16_t)(pk2(h * ge[t], 0.f) & 0xffffu);
            y2p[(size_t)t * LW] = (bf16_t)(pk2(P * ge[t], 0.f) & 0xffffu);
        }
        LDS_FENCE();
    }
    if (sample) p.out[OFF_NHS + (size_t)(tile - 128) * LW + c] = h;
    else ((f32x2*)(ws + WS_AGG))[(size_t)tile * LW + c] = (f32x2){P, h};
    }
}

__device__ __forceinline__ void fixup_item(const Params& p, LAS unsigned char* lds, int wave, int lane, int it) {
    unsigned char* ws = p.ws;
    const bf16_t* Y1 = (const bf16_t*)(ws + WS_Y12); const bf16_t* Y2 = Y1 + (size_t)MT * LW;
    bf16_t* mix = (bf16_t*)(ws + WS_MIX);
    LAS float* carry = (LAS float*)lds;
    const int tid = wave * 64 + lane;
    int row0;
    if (it < 256) {
        const int tile = it >> 1; row0 = it * 128;
        const f32x2* agg = (const f32x2*)(ws + WS_AGG);
        float cv = 0.f;
        for (int j0 = tile & ~63; j0 < tile; j0 += 32) {
            f32x2 au[32];
#pragma unroll
            for (int u = 0; u < 32; ++u) { const int j = (j0 + u < tile) ? j0 + u : tile - 1; au[u] = agg[(size_t)j * LW + tid]; }
#pragma unroll
            for (int u = 0; u < 32; ++u) if (j0 + u < tile) cv = au[u].x * cv + au[u].y;
        }
        carry[tid] = cv;
        if ((tile & 63) == 63 && (it & 1)) { const f32x2 au = agg[(size_t)tile * LW + tid]; p.out[OFF_NHP + (tile >> 6) * LW + tid] = au.x * cv + au.y; }
    } else { row0 = MP + (it - 256) * 128; carry[tid] = 0.f; }
    __syncthreads();
    f32x4 c0 = *(const LAS f32x4*)(carry + 8 * lane), c1 = *(const LAS f32x4*)(carry + 8 * lane + 4);
    const f32x4 g0 = *(const f32x4*)(p.in[I_GLRU] + 8 * lane), g1 = *(const f32x4*)(p.in[I_GLRU] + 8 * lane + 4);
    for (int rr = wave; rr < 128; rr += 32) {
        u32x4 a[4], b[4];
#pragma unroll
        for (int q = 0; q < 4; ++q) { const int r = row0 + rr + 8 * q; a[q] = *(const u32x4*)(Y1 + (size_t)r * LW + 8 * lane); b[q] = *(const u32x4*)(Y2 + (size_t)r * LW + 8 * lane); }
#pragma unroll
        for (int q = 0; q < 4; ++q) {
            const int r = row0 + rr + 8 * q;
            float v[8];
            v[0] = __uint_as_float(a[q].x << 16) + c0[0] * __uint_as_float(b[q].x << 16); v[1] = __uint_as_float(a[q].x & 0xffff0000u) + c0[1] * __uint_as_float(b[q].x & 0xffff0000u);
            v[2] = __uint_as_float(a[q].y << 16) + c0[2] * __uint_as_float(b[q].y << 16); v[3] = __uint_as_float(a[q].y & 0xffff0000u) + c0[3] * __uint_as_float(b[q].y & 0xffff0000u);
            v[4] = __uint_as_float(a[q].z << 16) + c1[0] * __uint_as_float(b[q].z << 16); v[5] = __uint_as_float(a[q].z & 0xffff0000u) + c1[1] * __uint_as_float(b[q].z & 0xffff0000u);
            v[6] = __uint_as_float(a[q].w << 16) + c1[2] * __uint_as_float(b[q].w << 16); v[7] = __uint_as_float(a[q].w & 0xffff0000u) + c1[3] * __uint_as_float(b[q].w & 0xffff0000u);
            float sq = 0.f;
#pragma unroll
            for (int i = 0; i < 8; ++i) sq += v[i] * v[i];
            const float rs = __builtin_amdgcn_rsqf(wave_sum(sq) * (1.f / LW) + EPS);
            u32x4 w; w.x = pk2(v[0] * rs * g0[0], v[1] * rs * g0[1]); w.y = pk2(v[2] * rs * g0[2], v[3] * rs * g0[3]);
            w.z = pk2(v[4] * rs * g1[0], v[5] * rs * g1[1]); w.w = pk2(v[6] * rs * g1[2], v[7] * rs * g1[3]);
            *(u32x4*)(mix + (size_t)r * DM + 512 + 8 * lane) = w;
        }
    }
    __syncthreads();
}

template <class Epi>
__device__ __forceinline__ void sgemm_n1024(LAS unsigned char* lds, const bf16_t* A, int lda, const bf16_t* Bt, int K, const Epi& E, int bx, int G, int wave, int lane) {
    const int fr = lane & 15, fq = lane >> 4, g = wave >> 2, kq = wave & 3, nkq = K / 256;
    for (int T0 = bx * 2; T0 < 512; T0 += 2 * G) {
        const int T = T0 + g, ct = T >> 5, rt = T & 31, row0 = MP + rt * 32;
        const bf16_t* ap = A + (size_t)(row0 + fr) * lda + kq * (K / 4) + 8 * fq;
        const bf16_t* bp = Bt + (size_t)(ct * 64 + fr) * K + kq * (K / 4) + 8 * fq;
        f32x4 acc[2][4];
#pragma unroll
        for (int mi = 0; mi < 2; ++mi)
#pragma unroll
            for (int ni = 0; ni < 4; ++ni) acc[mi][ni] = (f32x4){0.f, 0.f, 0.f, 0.f};
        bf16x8 fa[2][2][2], fb[2][4][2];
#define SG_LOAD(s, kk) do { const int ko_ = ((kk) < nkq ? (kk) : nkq - 1) * 64; \
        _Pragma("unroll") for (int mi = 0; mi < 2; ++mi) _Pragma("unroll") for (int ks = 0; ks < 2; ++ks) fa[s][mi][ks] = *(const bf16x8*)(ap + (size_t)mi * 16 * lda + ko_ + ks * 32); \
        _Pragma("unroll") for (int ni = 0; ni < 4; ++ni) _Pragma("unroll") for (int ks = 0; ks < 2; ++ks) fb[s][ni][ks] = *(const bf16x8*)(bp + (size_t)ni * 16 * K + ko_ + ks * 32); } while (0)
#define SG_MMA(s) do { _Pragma("unroll") for (int mi = 0; mi < 2; ++mi) _Pragma("unroll") for (int ni = 0; ni < 4; ++ni) _Pragma("unroll") for (int ks = 0; ks < 2; ++ks) \
        acc[mi][ni] = __builtin_amdgcn_mfma_f32_16x16x32_bf16(fb[s][ni][ks], fa[s][mi][ks], acc[mi][ni], 0, 0, 0); } while (0)
#define SG_SCHED __builtin_amdgcn_sched_barrier(0)
        SG_LOAD(0, 0); SG_SCHED;
        for (int k = 0; k < nkq; k += 2) {
            SG_LOAD(1, k + 1); SG_SCHED; SG_MMA(0); SG_SCHED;
            SG_LOAD(0, k + 2); SG_SCHED; if (k + 1 < nkq) SG_MMA(1); SG_SCHED;
        }
#undef SG_LOAD
#undef SG_MMA
#undef SG_SCHED
        LAS f32x4* red = (LAS f32x4*)lds;
        if (kq) {
#pragma unroll
            for (int mi = 0; mi < 2; ++mi)
#pragma unroll
                for (int ni = 0; ni < 4; ++ni) red[((g * 3 + (kq - 1)) * 64 + lane) * 8 + mi * 4 + ni] = acc[mi][ni];
        }
        __syncthreads();
        if (kq == 0) {
#pragma unroll
            for (int j = 0; j < 3; ++j)
#pragma unroll
                for (int mi = 0; mi < 2; ++mi)
#pragma unroll
                    for (int ni = 0; ni < 4; ++ni) acc[mi][ni] = acc[mi][ni] + red[((g * 3 + j) * 64 + lane) * 8 + mi * 4 + ni];
            E(acc, row0, ct, fr, fq);
        }
        __syncthreads();
    }
}
__device__ __forceinline__ u32x2 pk4(const f32x4 v) { u32x2 w; w.x = pk2(v[0], v[1]); w.y = pk2(v[2], v[3]); return w; }
__device__ __forceinline__ f32x4 unpk4(const u32x2 w) { return (f32x4){__uint_as_float(w.x << 16), __uint_as_float(w.x & 0xffff0000u), __uint_as_float(w.y << 16), __uint_as_float(w.y & 0xffff0000u)}; }
__device__ __forceinline__ float srow_rs(const float* sss, int r) {
    const float* q = sss + (size_t)(r - MP) * 16 * 32; float t = 0.f;
#pragma unroll
    for (int i = 0; i < 16; ++i) t += q[i * 32];
    return __builtin_amdgcn_rsqf(t * (1.f / DM) + EPS);
}
template <bool F32BASE> struct SEpiResid {
    const float* base_s; bf16_t* hb; float* ss;
    __device__ __forceinline__ void operator()(const f32x4 (&acc)[2][4], int row0, int ct, int fr, int fq) const {
#pragma unroll
        for (int mi = 0; mi < 2; ++mi) {
            const int r = row0 + mi * 16 + fr; float s = 0.f;
#pragma unroll
            for (int ni = 0; ni < 4; ++ni) { const int c = ct * 64 + ni * 16 + 4 * fq;
                f32x4 v = F32BASE ? *(const f32x4*)(base_s + (size_t)(r - MP) * DM + c) : unpk4(*(const u32x2*)(hb + (size_t)r * DM + c));
                v = v + acc[mi][ni]; s += (v[0] * v[0] + v[1] * v[1]) + (v[2] * v[2] + v[3] * v[3]);
                *(u32x2*)(hb + (size_t)r * DM + c) = pk4(v); }
            s += __shfl_xor(s, 16); s += __shfl_xor(s, 32);
            if (fq == 0) ss[((size_t)(r - MP) * 16 + ct) * 32] = s;
        }
    }
};

struct SEpiPleGate {
    const float* ss; const bf16_t* pp; const bf16_t* h2; bf16_t* h3;
    __device__ __forceinline__ void operator()(const f32x4 (&acc)[2][4], int row0, int ct, int fr, int fq) const {
#pragma unroll
        for (int mi = 0; mi < 2; ++mi) {
            const int r = row0 + mi * 16 + fr; const float rs = srow_rs(ss, r);
#pragma unroll
            for (int ni = 0; ni < 4; ++ni) { const size_t o = (size_t)r * DM + ct * 64 + ni * 16 + 4 * fq;
                const f32x4 pv = unpk4(*(const u32x2*)(pp + o)); f32x4 h = unpk4(*(const u32x2*)(h2 + o)); const f32x4 a = acc[mi][ni];
#pragma unroll
                for (int i = 0; i < 4; ++i) h[i] += pv[i] * sigmoid_f(a[i] * rs);
                *(u32x2*)(h3 + o) = pk4(h); }
        }
    }
};


#define XB_TMO      128
#define XB_XCNT(j)  (256  + 64 * (j))
#define XB_XSUB(j)  (1280 + 64 * (j))
#define XB_XGEN(j)  (2304 + 64 * (j))
#define XB_TOP      3328
#define XB_TOPGEN   3392
#define XCD_BAR_WORDS 3456
#define XB_SPIN_CAP (1u << 18)

__device__ __forceinline__ unsigned xb_ld(unsigned* p)              { return __hip_atomic_load(p, __ATOMIC_RELAXED, __HIP_MEMORY_SCOPE_AGENT); }
__device__ __forceinline__ unsigned xb_add(unsigned* p, unsigned v) { return __hip_atomic_fetch_add(p, v, __ATOMIC_RELAXED, __HIP_MEMORY_SCOPE_AGENT); }
__device__ __forceinline__ unsigned xb_xcc_id() { return (unsigned)__builtin_amdgcn_s_getreg((3 << 11) | 20) & 0xFu; }
#define XB_SPIN(cond, bar) do { unsigned _sp = 0; while (cond) { __builtin_amdgcn_s_sleep(1); \
    if ((++_sp & 255u) == 0u) { if (xb_ld(&(bar)[XB_TMO])) break; if (_sp > XB_SPIN_CAP) { atomicAdd(&(bar)[XB_TMO], 1u); break; } } } } while (0)

struct XcdBarrier { unsigned* bar; unsigned x; volatile LAS unsigned* st; };
__device__ __forceinline__ XcdBarrier xcd_barrier_post(unsigned* bar, volatile LAS unsigned* st, bool leader) {
    XcdBarrier b; b.bar = bar; b.x = xb_xcc_id(); b.st = st;
    if (leader) (void)xb_add(&bar[XB_XCNT(b.x)], 1u);
    return b;
}
__device__ __forceinline__ void xcd_barrier_complete(unsigned* bar, unsigned x, unsigned& nloc, unsigned& nx) {
    const unsigned G = gridDim.x * gridDim.y * gridDim.z;
    unsigned sum, cnt, mine, sp = 0u;
    for (;;) {
        sum = 0u; cnt = 0u; mine = 0u;
#pragma unroll
        for (unsigned j = 0; j < 16; ++j) { const unsigned c = xb_ld(&bar[XB_XCNT(j)]); sum += c; cnt += (c > 0u) ? 1u : 0u; mine = (j == x) ? c : mine; }
        if (sum == G) break;
        __builtin_amdgcn_s_sleep(1);
        if ((++sp & 255u) == 0u) { if (xb_ld(&bar[XB_TMO])) break; if (sp > XB_SPIN_CAP) { atomicAdd(&bar[XB_TMO], 1u); break; } }
    }
    nloc = mine > 0u ? mine : 1u; nx = cnt > 0u ? cnt : 1u;
}

__device__ __forceinline__ void xcd_barrier(const XcdBarrier& b, bool leader) {
    asm volatile("s_waitcnt vmcnt(0)" ::: "memory");
    __syncthreads();
    if (leader) {
        unsigned* bar = b.bar;
        __builtin_amdgcn_s_waitcnt(0);
        unsigned nloc = b.st[0], nx = b.st[1];
        if (nloc == 0u) { xcd_barrier_complete(bar, b.x, nloc, nx); b.st[0] = nloc; b.st[1] = nx; }
        const unsigned old = xb_add(&bar[XB_XSUB(b.x)], 1u);
        const unsigned gen = old / nloc;
        if (old + 1u == (gen + 1u) * nloc) {
            __builtin_amdgcn_fence(__ATOMIC_RELEASE, "agent");
            asm volatile("s_waitcnt vmcnt(0)" ::: "memory");
            const unsigned og = xb_add(&bar[XB_TOP], 1u);
            const unsigned tg = og / nx;
            if (og + 1u == (tg + 1u) * nx) xb_add(&bar[XB_TOPGEN], 1u);
            else XB_SPIN(xb_ld(&bar[XB_TOPGEN]) == tg, bar);
            __builtin_amdgcn_fence(__ATOMIC_ACQUIRE, "agent");
            xb_add(&bar[XB_XGEN(b.x)], 1u);
            asm volatile("s_waitcnt vmcnt(0)" ::: "memory");
        } else {
            XB_SPIN(xb_ld(&bar[XB_XGEN(b.x)]) == gen, bar);
            __builtin_amdgcn_fence(__ATOMIC_ACQUIRE, "agent");
            asm volatile("s_waitcnt vmcnt(0)" ::: "memory");
        }
    }
    __syncthreads();
}

__global__ void __launch_bounds__(512, 2) fwd_megakernel(Params p) {
    extern __shared__ __attribute__((aligned(16))) unsigned char lds_raw[];
    LAS unsigned char* lds = (LAS unsigned char*)lds_raw;
    cg::grid_group grid = cg::this_grid();
    const int wave = __builtin_amdgcn_readfirstlane((int)threadIdx.x >> 6);
#define LANE_NOW(l) int l = __builtin_amdgcn_mbcnt_hi(~0u, __builtin_amdgcn_mbcnt_lo(~0u, 0u)); asm volatile("" : "+v"(l))
    const int G = gridDim.x, bx = blockIdx.x;
    unsigned char* ws = p.ws;
    const int lo = p.ph_lo, hi = p.ph_hi;
    { LANE_NOW(l0_); if (wave == 0 && l0_ < 2) ((volatile LAS unsigned*)(lds + 131072))[l0_] = 0u; }
    __syncthreads();
    XcdBarrier xbar; xbar.bar = (unsigned*)(ws + WS_BAR); xbar.x = 0; xbar.st = (volatile LAS unsigned*)(lds + 131072);
    if (lo == 0 && hi > 1) {
        if (bx == 0) { LANE_NOW(l0_); const int t_ = wave * 64 + l0_;
            for (int i = t_; i < XCD_BAR_WORDS; i += 512) __hip_atomic_store((unsigned*)(ws + WS_BAR) + i, 0u, __ATOMIC_RELAXED, __HIP_MEMORY_SCOPE_AGENT);
            if (t_ < 16) __hip_atomic_store((unsigned*)(ws + WS_CTR) + 64 * t_, 0u, __ATOMIC_RELAXED, __HIP_MEMORY_SCOPE_AGENT);
            asm volatile("s_waitcnt vmcnt(0)" ::: "memory"); }
        grid.sync();
        { LANE_NOW(l0_); xbar = xcd_barrier_post((unsigned*)(ws + WS_BAR), (volatile LAS unsigned*)(lds + 131072), wave == 0 && l0_ == 0); }
    }
#ifndef REP0
#define REP0 1
#endif
#ifndef REP2
#define REP2 1
#endif
#ifndef REP1
#define REP1 1
#endif
#ifndef REP3
#define REP3 1
#endif
#ifndef REP4
#define REP4 1
#endif
#ifndef REP5
#define REP5 1
#endif
#ifndef PHMASK
#define PHMASK 0x1ff
#endif
#define IN(k) (((PHMASK >> (k)) & 1) && lo <= (k) && (k) < hi)
#define SEAM(k) do { if (IN(k) && IN((k) + 1)) { LANE_NOW(l0_); xcd_barrier(xbar, wave == 0 && l0_ == 0); } } while (0)

    for (int rep0 = 0; rep0 < REP0; ++rep0) if (IN(0)) { LANE_NOW(lane);  p0_prologue(p, lds, wave, lane, 0, bx * 8 + wave, G * 8); }
    SEAM(0);
    for (int rep1 = 0; rep1 < REP1; ++rep1) if (IN(1)) {
        pg8::Gemm g{(const bf16_t*)(ws + WS_XN), (const bf16_t*)(ws + WS_WIN), MT, INW, DM}; pg8::StaticOrder S; S.init(MT, INW, G, bx);
        pg8::EpiInProj E{(bf16_t*)(ws + WS_PROJ), (bf16_t*)(ws + WS_VT), p.out};
        pg8::gemm_phase<pg8::EpiInProj, pg8::StaticOrder, true, true>(lds, g, S, E, wave);
    }
    SEAM(1);
    for (int rep2 = 0; rep2 < REP2; ++rep2) if (IN(2)) {
        LANE_NOW(lane); const int tid = wave * 64 + lane;
        for (int i = tid; i < NHEAD * RELSZ; i += 512) ((LAS float*)lds)[i] = p.in[I_REL][i] * LOG2E;
        __syncthreads();
        constexpr int N_LRU = 160, N_ATT = NBATCH * 256;
        unsigned* ctr = (unsigned*)(ws + WS_CTR);
        volatile LAS int* qslot = (volatile LAS int*)(lds + 12288);
#define Q_NEXT(k, it) do { if (tid == 0) qslot[0] = (int)__hip_atomic_fetch_add(ctr + 64 * (k), 1u, __ATOMIC_RELAXED, __HIP_MEMORY_SCOPE_AGENT); __syncthreads(); it = qslot[0]; __syncthreads(); } while (0)
#ifndef NO_LRU
        lru_queue(p, lds, wave, lane, ctr, N_LRU);
#endif
        asm volatile("" ::: "memory");
#ifndef NO_ATT4
        { const int myq = (int)(xb_xcc_id() & 7u);
          for (;;) {
              if (tid == 0) {
                  int q = myq; int it = (int)__hip_atomic_fetch_add(ctr + 64 * (4 + q), 1u, __ATOMIC_RELAXED, __HIP_MEMORY_SCOPE_AGENT);
                  while (it >= 64) {
                      int best = -1; unsigned bestv = 64u;
                      for (int j = 0; j < 8; ++j) { const unsigned v = __hip_atomic_load(ctr + 64 * (4 + j), __ATOMIC_RELAXED, __HIP_MEMORY_SCOPE_AGENT); if (v < bestv) { bestv = v; best = j; } }
                      if (best < 0) { q = -1; break; }
                      q = best; it = (int)__hip_atomic_fetch_add(ctr + 64 * (4 + q), 1u, __ATOMIC_RELAXED, __HIP_MEMORY_SCOPE_AGENT);
                  }
                  qslot[0] = q < 0 ? -1 : ((q << 8) | it);
              }
              __syncthreads(); const int v = qslot[0]; __syncthreads();
              if (v < 0) break;
              attn_item<4>(p, lds, wave, lane, false, v >> 10, ((v >> 8) & 3) * 64 + (v & 255));
          } }
#endif
        asm volatile("" ::: "memory");
#ifndef NO_ATT2
        for (;;) { int it; Q_NEXT(2, it); if (it >= SBATCH) break; attn_item<2>(p, lds, wave, lane, true, it, 0); }
#endif
#undef Q_NEXT
        __syncthreads();
    }
    SEAM(2);
    for (int rep3 = 0; rep3 < REP3; ++rep3) if (IN(3)) { LANE_NOW(lane); for (int it = bx; it < 264; it += G) fixup_item(p, lds, wave, lane, it); }
    SEAM(3);
    for (int rep4 = 0; rep4 < REP4; ++rep4) if (IN(4)) {
        pg8::Gemm g{(const bf16_t*)(ws + WS_MIX), (const bf16_t*)(ws + WS_WO), MT, DM, DM}; pg8::StaticOrder S; S.init(MT, DM, G, bx);
        pg8::EpiResid<true> E{p.in[I_XP], p.in[I_XS], (bf16_t*)(ws + WS_XN), (float*)(ws + WS_SS1)};
        pg8::gemm_phase<pg8::EpiResid<true>, pg8::StaticOrder, true, true>(lds, g, S, E, wave);
        __syncthreads();
        { const int n3 = (MT / 256) * (DM / 256) - 2 * G; const bool spread = n3 > 0 && n3 < G;
          pg8::Gemm g2{(const bf16_t*)(ws + WS_PB), (const bf16_t*)(ws + WS_WPP), MT, DM, PLE}; pg8::StaticOrder S2;
          if (spread) S2.init(MT, DM, G - n3, bx >= n3 ? bx - n3 : (1 << 28)); else S2.init(MT, DM, G, bx);
          pg8::EpiStoreBf16 E2{(bf16_t*)(p.out + OFF_Y)};
          pg8::gemm_phase<pg8::EpiStoreBf16, pg8::StaticOrder, true, true>(lds, g2, S2, E2, wave);
          __syncthreads();
          LANE_NOW(lane);
          if (spread) { if (bx >= n3) p0_prologue(p, lds, wave, lane, 1, (bx - n3) * 8 + wave, (G - n3) * 8); } else p0_prologue(p, lds, wave, lane, 1, bx * 8 + wave, G * 8); }
    }
    SEAM(4);
    for (int rep5 = 0; rep5 < REP5; ++rep5) if (IN(5)) {
        pg8::Gemm g{(const bf16_t*)(ws + WS_XN), (const bf16_t*)(ws + WS_WGU), MT, 2 * DFF, DM}; pg8::StaticOrder S; S.init(MT, 2 * DFF, G, bx);
        pg8::EpiSwiglu E{(const float*)(ws + WS_SS1), (bf16_t*)(ws + WS_PROJ)};
        pg8::gemm_phase<pg8::EpiSwiglu, pg8::StaticOrder, true, true>(lds, g, S, E, wave);
    }
    SEAM(5);
    if (IN(6)) {
        pg8::Gemm g{(const bf16_t*)(ws + WS_PROJ), (const bf16_t*)(ws + WS_WD), MP, DM, DFF}; pg8::StaticOrder S; S.init(MP, DM, G, bx);
        pg8::EpiResid<false> E{nullptr, nullptr, (bf16_t*)(ws + WS_XN), (float*)(ws + WS_SS2)};
        pg8::gemm_phase<pg8::EpiResid<false>, pg8::StaticOrder, true, true>(lds, g, S, E, wave);
        __syncthreads();
        { LANE_NOW(lane); SEpiResid<false> SE{nullptr, (bf16_t*)(ws + WS_XN), (float*)(ws + WS_SSS2)};
          sgemm_n1024<SEpiResid<false>>(lds, (const bf16_t*)(ws + WS_PROJ), DFF, (const bf16_t*)(ws + WS_WD), DFF, SE, bx, G, wave, lane); }
    }
    SEAM(6);
    if (IN(7)) {
#ifndef NO_P7B
        { pg8::Gemm g{(const bf16_t*)(ws + WS_XN), (const bf16_t*)(ws + WS_WPG), MP, DM, DM}; pg8::StaticOrder S; S.init(MP, DM, G, bx);
          pg8::EpiPleGate E{(const float*)(ws + WS_SS2), (const float*)(ws + WS_SSS2), (const bf16_t*)(p.out + OFF_Y), (const bf16_t*)(ws + WS_XN), (bf16_t*)(ws + WS_MIX)};
          pg8::gemm_phase<pg8::EpiPleGate, pg8::StaticOrder, true, true>(lds, g, S, E, wave); }
#endif
        __syncthreads();
        { LANE_NOW(lane); SEpiPleGate SE{(const float*)(ws + WS_SSS2), (const bf16_t*)(p.out + OFF_Y), (const bf16_t*)(ws + WS_XN), (bf16_t*)(ws + WS_MIX)};
          sgemm_n1024<SEpiPleGate>(lds, (const bf16_t*)(ws + WS_XN), DM, (const bf16_t*)(ws + WS_WPG), DM, SE, bx, G, wave, lane); }
    }
    SEAM(7);
    if (IN(8)) {
        LANE_NOW(lane);
        const f32x4* gf = (const f32x4*)p.in[I_GFINAL];
        const bf16_t* h3 = (const bf16_t*)(ws + WS_MIX);
        for (int m0 = bx * 8 + wave; m0 < MT; m0 += 2 * G * 8) {
            const int m1 = (m0 + G * 8 < MT) ? m0 + G * 8 : m0;
            u32x4 ld[2][2];
            ld[0][0] = ((const u32x4*)(h3 + (size_t)m0 * DM))[lane]; ld[0][1] = ((const u32x4*)(h3 + (size_t)m0 * DM))[lane + 64];
            ld[1][0] = ((const u32x4*)(h3 + (size_t)m1 * DM))[lane]; ld[1][1] = ((const u32x4*)(h3 + (size_t)m1 * DM))[lane + 64];
#pragma unroll
            for (int q = 0; q < 2; ++q) {
                if (q == 1 && m1 == m0) break;
                const int m = q ? m1 : m0; const u32x4 a = ld[q][0], b = ld[q][1];
                float v[16];
                v[0] = __uint_as_float(a.x << 16); v[1] = __uint_as_float(a.x & 0xffff0000u); v[2] = __uint_as_float(a.y << 16); v[3] = __uint_as_float(a.y & 0xffff0000u);
                v[4] = __uint_as_float(a.z << 16); v[5] = __uint_as_float(a.z & 0xffff0000u); v[6] = __uint_as_float(a.w << 16); v[7] = __uint_as_float(a.w & 0xffff0000u);
                v[8] = __uint_as_float(b.x << 16); v[9] = __uint_as_float(b.x & 0xffff0000u); v[10] = __uint_as_float(b.y << 16); v[11] = __uint_as_float(b.y & 0xffff0000u);
                v[12] = __uint_as_float(b.z << 16); v[13] = __uint_as_float(b.z & 0xffff0000u); v[14] = __uint_as_float(b.w << 16); v[15] = __uint_as_float(b.w & 0xffff0000u);
                float sq = 0.f;
#pragma unroll
                for (int i = 0; i < 16; ++i) sq += v[i] * v[i];
                const float rs = __builtin_amdgcn_rsqf(wave_sum(sq) * (1.f / DM) + EPS);
                f32x4* yr = (f32x4*)(p.out + OFF_Y + (size_t)m * DM);
#pragma unroll
                for (int qq = 0; qq < 4; ++qq) { const int ci = (qq < 2 ? 2 * lane + qq : 128 + 2 * lane + (qq - 2)); const f32x4 g = gf[ci];
                    yr[ci] = (f32x4){v[4 * qq] * rs * g[0], v[4 * qq + 1] * rs * g[1], v[4 * qq + 2] * rs * g[2], v[4 * qq + 3] * rs * g[3]}; }
            }
        }
    }
#undef IN
#undef SEAM
}

extern "C" void kernel_launch(void* const* d_in, const int* in_sizes, int n_in, void* d_out, int out_size, void* d_ws, size_t ws_size, hipStream_t stream) {
    static int grid = 0;
    if (grid == 0) {
        if (n_in != 29 || (size_t)out_size != OUT_TOTAL || ws_size < WS_END) { fprintf(stderr, "kernel_launch: shape mismatch (n_in %d, out %d, ws %zu need %zu)\n", n_in, out_size, ws_size, (size_t)WS_END); grid = -1; return; }
        int dev = 0, cus = 0, per_cu = 0;
        hipGetDevice(&dev); hipDeviceGetAttribute(&cus, hipDeviceAttributeMultiprocessorCount, dev);
        if (hipFuncSetAttribute((const void*)fwd_megakernel, hipFuncAttributeMaxDynamicSharedMemorySize, LDS_BYTES) != hipSuccess) { fprintf(stderr, "kernel_launch: hipFuncSetAttribute failed\n"); grid = -1; return; }
        if (hipOccupancyMaxActiveBlocksPerMultiprocessor(&per_cu, (const void*)fwd_megakernel, 512, LDS_BYTES) != hipSuccess || per_cu < 1) { fprintf(stderr, "kernel_launch: occupancy query says %d\n", per_cu); per_cu = 1; }
        (void)hipGetLastError();
        grid = cus * (per_cu > 1 ? 1 : per_cu);
    }
    if (grid < 0) return;
    Params p{};
    for (int i = 0; i < 29; ++i) p.in[i] = (const float*)d_in[i];
    p.out = (float*)d_out; p.ws = (unsigned char*)d_ws;
#if MK_N_LAUNCHES == 1
    p.ph_lo = 0; p.ph_hi = 9;
    void* args[] = {&p};
    hipError_t e = hipLaunchCooperativeKernel((const void*)fwd_megakernel, dim3(grid), dim3(512), args, LDS_BYTES, stream);
    if (e != hipSuccess) fprintf(stderr, "cooperative launch failed: %s (grid %d)\n", hipGetErrorString(e), grid);
#else
    for (int k = 0; k < 9; ++k) { p.ph_lo = k; p.ph_hi = k + 1; hipLaunchKernelGGL(fwd_megakernel, dim3(grid), dim3(512), LDS_BYTES, stream, p); }
#endif
}
```
